# Optimizing an MI355X kernel written in HIP

```python
import math
import jax, jax.numpy as jnp
from jax import lax
import numpy as np


D_MODEL = 1024
BATCH = 2
SEQ = 8192
DEPTH = 1
DEC_BATCH = 32
DEC_SEQ = 4
PAST_LEN = 8192
PAGE_SIZE = 128

N_HEADS_A = 4
HEAD_DIM_A = (D_MODEL // 2) // (2 * N_HEADS_A)
N_HEADS_B = 4
KEY_DIM_B = (D_MODEL // 2) // N_HEADS_B
VAL_DIM_B = KEY_DIM_B
D_FF = 2816
CONV_W = 3

ROPE_THETA = 10000.0
Q_BLOCK = 128
GLA_CHUNK = 64
LN_EPS = 1e-5
RMS_EPS = 1e-5
ALPHA = (2 * DEPTH) ** 0.25
BETA = (8 * DEPTH) ** -0.25

QA_DIM = N_HEADS_A * 2 * HEAD_DIM_A
KA_DIM = N_HEADS_A * 2 * HEAD_DIM_A
VA_DIM = N_HEADS_A * 2 * HEAD_DIM_A
QB_DIM = N_HEADS_B * KEY_DIM_B
FB_DIM = N_HEADS_B * KEY_DIM_B
IB_DIM = N_HEADS_B * VAL_DIM_B
GB_DIM = N_HEADS_B * VAL_DIM_B
IN_SIZES = (QA_DIM, KA_DIM, VA_DIM, QB_DIM, FB_DIM, IB_DIM, GB_DIM, D_MODEL, D_MODEL)
IN_COLS = sum(IN_SIZES)

kernel_name = 'hybrid_diffattn_hgrn2_convffn_step'


def layer_norm(x, g, b):
    xf = x.astype(jnp.float32)
    mu = jnp.mean(xf, -1, keepdims=True)
    var = jnp.mean(jnp.square(xf - mu), -1, keepdims=True)
    return ((xf - mu) * lax.rsqrt(var + LN_EPS) * g.astype(jnp.float32) + b.astype(jnp.float32)).astype(x.dtype)


def rms_norm(x, g):
    xf = x.astype(jnp.float32)
    return (xf * lax.rsqrt(jnp.mean(xf * xf, -1, keepdims=True) + RMS_EPS) * g.astype(jnp.float32)).astype(x.dtype)


def rope(x, pos):
    half = HEAD_DIM_A // 2
    inv = ROPE_THETA ** (-jnp.arange(half, dtype=jnp.float32) * 2.0 / HEAD_DIM_A)
    ang = pos.astype(jnp.float32)[:, None] * inv[None, :]
    cos = jnp.cos(ang)[:, None, None, :].astype(x.dtype)
    sin = jnp.sin(ang)[:, None, None, :].astype(x.dtype)
    x1, x2 = x[..., :half], x[..., half:]
    return jnp.concatenate([x1 * cos - x2 * sin, x2 * cos + x1 * sin], -1)


def mixer_inputs(x, pos, w_in_l, lb_l):
    B, T, _ = x.shape
    proj = x @ w_in_l
    offs = np.cumsum(IN_SIZES)[:-1].tolist()
    qa, ka, va, qb, fb, ib, gb, ga, gg = jnp.split(proj, offs, axis=-1)
    qa = rope(qa.reshape(B, T, N_HEADS_A, 2, HEAD_DIM_A), pos)
    ka = rope(ka.reshape(B, T, N_HEADS_A, 2, HEAD_DIM_A), pos)
    va = va.reshape(B, T, N_HEADS_A, 2 * HEAD_DIM_A)
    lb = lb_l.astype(jnp.float32)
    fr = fb.astype(jnp.float32)
    logf = jnp.logaddexp(jnp.log(lb), jnp.log1p(-lb) + jax.nn.log_sigmoid(fr))
    kb = (1.0 - lb) * jax.nn.sigmoid(-fr)
    qb = qb.reshape(B, T, N_HEADS_B, KEY_DIM_B)
    kb = kb.reshape(B, T, N_HEADS_B, KEY_DIM_B)
    logf = logf.reshape(B, T, N_HEADS_B, KEY_DIM_B)
    ib = ib.reshape(B, T, N_HEADS_B, VAL_DIM_B)
    gb = gb.reshape(B, T, N_HEADS_B, VAL_DIM_B)
    return qa, ka, va, qb, kb, logf, ib, gb, ga, gg


def diff_attention(q, ks, vs, masks, lam):
    scale = HEAD_DIM_A ** -0.5
    s = jnp.concatenate([jnp.einsum('bqhmd,bkhmd->bhmqk', q, k, preferred_element_type=jnp.float32) * scale
                         for k in ks], -1)
    mask = jnp.concatenate(masks, -1)
    p = jax.nn.softmax(jnp.where(mask, s, -jnp.inf), axis=-1)
    a = (p[:, :, 0] - lam * p[:, :, 1]).astype(vs[0].dtype)
    offs = np.cumsum([0] + [k.shape[1] for k in ks]).tolist()
    return sum(jnp.einsum('bhqk,bkhe->bqhe', a[..., offs[i]:offs[i + 1]], vs[i]) for i in range(len(ks)))


def prompt_diff_attention(q, k, v, lam):
    B, T = q.shape[0], q.shape[1]
    nb = T // Q_BLOCK
    qb = q.reshape(B, nb, Q_BLOCK, N_HEADS_A, 2, HEAD_DIM_A).swapaxes(0, 1)
    starts = jnp.arange(nb) * Q_BLOCK
    kpos = jnp.arange(T)

    def one_block(args):
        qblk, st = args
        mask = kpos[None, :] <= (st + jnp.arange(Q_BLOCK))[:, None]
        return diff_attention(qblk, (k,), (v,), (mask,), lam)

    o = lax.map(one_block, (qb, starts))
    return o.swapaxes(0, 1).reshape(B, T, N_HEADS_A, 2 * HEAD_DIM_A)


def hgrn2_scan(q, k, v, logf, s0):
    B, T, H, _ = q.shape
    C = math.gcd(T, GLA_CHUNK)
    n = T // C

    def to_chunks(a):
        return a.astype(jnp.float32).reshape(B, n, C, H, a.shape[-1]).transpose(1, 0, 3, 2, 4)

    causal = jnp.tril(jnp.ones((C, C), bool))

    def step(S, xs):
        qc, kc, vc, lc = xs
        b = jnp.cumsum(lc, axis=2)
        o_inter = jnp.einsum('bhtk,bhkv->bhtv', qc * jnp.exp(b), S)
        diff = jnp.where(causal[None, None, :, :, None], b[:, :, :, None, :] - b[:, :, None, :, :], -jnp.inf)
        att = jnp.einsum('bhtk,bhsk,bhtsk->bhts', qc, kc, jnp.exp(diff))
        o = o_inter + jnp.einsum('bhts,bhsv->bhtv', att, vc)
        b_last = b[:, :, -1:, :]
        S_new = jnp.exp(b_last[:, :, 0, :])[..., None] * S + jnp.einsum('bhsk,bhsv->bhkv', kc * jnp.exp(b_last - b), vc)
        return S_new, o

    S, o = lax.scan(step, s0.astype(jnp.float32), (to_chunks(q), to_chunks(k), to_chunks(v), to_chunks(logf)))
    o = o.transpose(1, 0, 3, 2, 4).reshape(B, T, H, VAL_DIM_B)
    return o, S


def finish_layer(x, oa, ob, gb, ga, gg, conv0, l, hgrn_norm_g, w_branch_a, w_branch_b, w_out,
                 ln1_g, ln1_b, w_up, conv_w, conv_b, w_down, ln2_g, ln2_b):
    B, T, _ = x.shape
    ob = rms_norm(ob.astype(x.dtype), hgrn_norm_g[l]) * jax.nn.silu(gb)
    merged = (jax.nn.sigmoid(ga) * (oa.reshape(B, T, -1) @ w_branch_a[l])
              + jax.nn.sigmoid(gg) * (ob.reshape(B, T, -1) @ w_branch_b[l]))
    h = layer_norm(ALPHA * x + merged @ w_out[l], ln1_g[l], ln1_b[l])
    a, g = jnp.split(h @ w_up[l], 2, axis=-1)
    ap = jnp.concatenate([conv0.astype(a.dtype), a], axis=1)
    c = conv_b[l] + sum(ap[:, j:j + T] * conv_w[l, j] for j in range(CONV_W))
    y = (jax.nn.gelu(c, approximate=False) * g) @ w_down[l]
    out = layer_norm(ALPHA * h + y, ln2_g[l], ln2_b[l])
    return out, ap[:, -(CONV_W - 1):]


def setup_inputs(seed: int = 0) -> dict:
    key = jax.random.key(seed)
    ks = jax.random.split(key, 32)
    f32 = jnp.float32

    def nrm(k, shape, s):
        return jax.random.normal(k, shape, f32) * s

    n_pages = PAST_LEN // PAGE_SIZE
    n_used = DEC_BATCH * n_pages
    n_phys = n_used + n_used // 4
    page_table = jax.random.permutation(ks[4], n_phys)[:n_used].reshape(DEC_BATCH, n_pages).astype(jnp.int32)
    return {
        'x_prompt': nrm(ks[0], (BATCH, SEQ, D_MODEL), 1.0),
        'x_sample': nrm(ks[1], (DEC_BATCH, DEC_SEQ, D_MODEL), 1.0),
        'cache_k': nrm(ks[2], (n_phys, DEPTH, PAGE_SIZE, N_HEADS_A, 2, HEAD_DIM_A), 1.0),
        'cache_v': nrm(ks[3], (n_phys, DEPTH, PAGE_SIZE, N_HEADS_A, 2 * HEAD_DIM_A), 1.0),
        'state_hgrn': nrm(ks[5], (DEC_BATCH, DEPTH, N_HEADS_B, KEY_DIM_B, VAL_DIM_B), 0.5),
        'state_conv': nrm(ks[6], (DEC_BATCH, DEPTH, CONV_W - 1, D_FF), 1.0),
        'page_table': page_table,
        'w_in': nrm(ks[7], (DEPTH, D_MODEL, IN_COLS), D_MODEL ** -0.5),
        'lambda_q1': nrm(ks[8], (DEPTH, HEAD_DIM_A), 0.1),
        'lambda_k1': nrm(ks[9], (DEPTH, HEAD_DIM_A), 0.1),
        'lambda_q2': nrm(ks[10], (DEPTH, HEAD_DIM_A), 0.1),
        'lambda_k2': nrm(ks[11], (DEPTH, HEAD_DIM_A), 0.1),
        'subln_g': 1.0 + nrm(ks[12], (DEPTH, 2 * HEAD_DIM_A), 0.02),
        'lb_logits': nrm(ks[13], (DEPTH + 1, N_HEADS_B * KEY_DIM_B), 0.1),
        'hgrn_norm_g': 1.0 + nrm(ks[14], (DEPTH, VAL_DIM_B), 0.02),
        'w_branch_a': nrm(ks[15], (DEPTH, VA_DIM, D_MODEL), VA_DIM ** -0.5),
        'w_branch_b': nrm(ks[16], (DEPTH, IB_DIM, D_MODEL), IB_DIM ** -0.5),
        'w_out': nrm(ks[17], (DEPTH, D_MODEL, D_MODEL), BETA * D_MODEL ** -0.5),
        'ln1_g': 1.0 + nrm(ks[18], (DEPTH, D_MODEL), 0.02),
        'ln1_b': nrm(ks[19], (DEPTH, D_MODEL), 0.02),
        'w_up': nrm(ks[20], (DEPTH, D_MODEL, 2 * D_FF), D_MODEL ** -0.5),
        'conv_w': nrm(ks[21], (DEPTH, CONV_W, D_FF), CONV_W ** -0.5),
        'conv_b': nrm(ks[22], (DEPTH, D_FF), 0.02),
        'w_down': nrm(ks[23], (DEPTH, D_FF, D_MODEL), BETA * D_FF ** -0.5),
        'ln2_g': 1.0 + nrm(ks[24], (DEPTH, D_MODEL), 0.02),
        'ln2_b': nrm(ks[25], (DEPTH, D_MODEL), 0.02),
    }


def reference(x_prompt, x_sample, cache_k, cache_v, state_hgrn, state_conv, page_table,
              w_in, lambda_q1, lambda_k1, lambda_q2, lambda_k2, subln_g, lb_logits, hgrn_norm_g,
              w_branch_a, w_branch_b, w_out, ln1_g, ln1_b, w_up, conv_w, conv_b, w_down, ln2_g, ln2_b):
    f32 = jnp.float32
    Bp, Tp = x_prompt.shape[0], x_prompt.shape[1]
    Bs, Ts = x_sample.shape[0], x_sample.shape[1]
    past_len = page_table.shape[1] * cache_k.shape[2]
    pos_p = jnp.arange(Tp)
    pos_s = past_len + jnp.arange(Ts)
    lb_all = jnp.cumsum(jax.nn.softmax(lb_logits.astype(f32), axis=0), axis=0)
    sample_masks = (jnp.ones((Ts, past_len), bool), jnp.tril(jnp.ones((Ts, Ts), bool)))
    ffn_args = (hgrn_norm_g, w_branch_a, w_branch_b, w_out, ln1_g, ln1_b, w_up, conv_w, conv_b, w_down, ln2_g, ln2_b)

    xp, xs = x_prompt, x_sample
    kp_l, vp_l, sp_l, cp_l, ks_l, vs_l, ss_l, cs_l = [], [], [], [], [], [], [], []
    for l in range(DEPTH):
        lam_init = 0.8 - 0.6 * math.exp(-0.3 * l)
        lam = (jnp.exp(jnp.sum(lambda_q1[l].astype(f32) * lambda_k1[l].astype(f32)))
               - jnp.exp(jnp.sum(lambda_q2[l].astype(f32) * lambda_k2[l].astype(f32))) + lam_init)

        qa, ka, va, qb, kb, logf, ib, gb, ga, gg = mixer_inputs(xp, pos_p, w_in[l], lb_all[l])
        oa = prompt_diff_attention(qa, ka, va, lam)
        oa = rms_norm(oa, subln_g[l]) * (1.0 - lam_init)
        s0 = jnp.zeros((Bp, N_HEADS_B, KEY_DIM_B, VAL_DIM_B), f32)
        ob, S_p = hgrn2_scan(qb, kb, ib, logf, s0)
        conv0 = jnp.zeros((Bp, CONV_W - 1, D_FF), xp.dtype)
        xp_new, conv_p = finish_layer(xp, oa, ob, gb, ga, gg, conv0, l, *ffn_args)
        kp_l.append(ka); vp_l.append(va); sp_l.append(S_p.astype(xp.dtype)); cp_l.append(conv_p)

        qa, ka, va, qb, kb, logf, ib, gb, ga, gg = mixer_inputs(xs, pos_s, w_in[l], lb_all[l])
        k_past = cache_k[page_table, l].reshape(Bs, past_len, N_HEADS_A, 2, HEAD_DIM_A)
        v_past = cache_v[page_table, l].reshape(Bs, past_len, N_HEADS_A, 2 * HEAD_DIM_A)
        oa = diff_attention(qa, (k_past.astype(ka.dtype), ka), (v_past.astype(va.dtype), va), sample_masks, lam)
        oa = rms_norm(oa, subln_g[l]) * (1.0 - lam_init)
        ob, S_s = hgrn2_scan(qb, kb, ib, logf, state_hgrn[:, l])
        xs_new, conv_s = finish_layer(xs, oa, ob, gb, ga, gg, state_conv[:, l], l, *ffn_args)
        ks_l.append(ka); vs_l.append(va); ss_l.append(S_s.astype(xs.dtype)); cs_l.append(conv_s)

        xp, xs = xp_new, xs_new

    k_prompt = jnp.stack(kp_l, axis=1)
    v_prompt = jnp.stack(vp_l, axis=1)
    hgrn_prompt = jnp.stack(sp_l, axis=1)
    conv_prompt = jnp.stack(cp_l, axis=1)
    k_sample = jnp.stack(ks_l, axis=1)
    v_sample = jnp.stack(vs_l, axis=1)
    hgrn_sample = jnp.stack(ss_l, axis=1)
    conv_sample = jnp.stack(cs_l, axis=1)
    return (xp, xs, k_prompt, v_prompt, hgrn_prompt, conv_prompt, k_sample, v_sample, hgrn_sample, conv_sample)
```

```cpp
#include <hip/hip_runtime.h>
#include <math.h>
#include <stdio.h>
#include <stdint.h>

constexpr int DM = 1024, NB = 2, SEQ = 8192, MP = NB * SEQ, DB = 32, DS = 4, MS = DB * DS, MT = MP + MS;
constexpr int PAST = 8192, PAGE = 128, NPG = PAST / PAGE;
constexpr int INC = 5632, DFF = 2816, NH = 4;
constexpr int C_QA = 0, C_KA = 512, C_VA = 1024, C_QB = 1536, C_FB = 2048, C_IB = 2560, C_GB = 3072, C_GA = 3584, C_GG = 4608;
constexpr float ALPHA = 1.189207115002721f;
constexpr float LN_EPS = 1e-5f, RMS_EPS = 1e-5f;
constexpr float LAM_INIT = 0.2f;

constexpr size_t O_YP = 0, O_YS = O_YP + (size_t)MP * DM, O_KP = O_YS + (size_t)MS * DM, O_VP = O_KP + (size_t)MP * 512,
                 O_HP = O_VP + (size_t)MP * 512, O_CP = O_HP + (size_t)NB * NH * 128 * 128, O_KS = O_CP + (size_t)NB * 2 * DFF,
                 O_VS = O_KS + (size_t)MS * 512, O_HS = O_VS + (size_t)MS * 512, O_CS = O_HS + (size_t)DB * NH * 128 * 128,
                 O_END = O_CS + (size_t)DB * 2 * DFF;

constexpr size_t W_MISC = 0;
constexpr size_t W_ROPE = 1024;
constexpr size_t W_PROJ = W_ROPE + (size_t)8196 * 64 + 1024;
constexpr size_t W_QR = W_PROJ + (size_t)MT * INC;
constexpr size_t W_KR = W_QR + (size_t)MT * 512;
constexpr size_t W_F = W_KR + (size_t)MT * 512;
constexpr size_t W_KB = W_F + (size_t)MT * 512;
constexpr size_t W_OA = W_KB + (size_t)MT * 512;
constexpr size_t W_OB = W_OA + (size_t)MT * 512;
constexpr size_t W_TA = W_OB + (size_t)MT * 512;
constexpr size_t W_TB = W_TA + (size_t)MT * DM;
constexpr size_t W_MG = W_TB + (size_t)MT * DM;
constexpr size_t W_HPRE = W_MG + (size_t)MT * DM;
constexpr size_t W_H = W_HPRE + (size_t)MT * DM;
constexpr size_t W_U = W_H + (size_t)MT * DM;
constexpr size_t W_Y = W_U + (size_t)MT * DFF;
constexpr size_t W_SC = W_Y + (size_t)MT * DM;
constexpr size_t W_SS = W_SC + (size_t)2 * SEQ * SEQ;
constexpr size_t W_END = W_SS + (size_t)DB * NH * 2 * DS * 8196;

__device__ __forceinline__ float sigmoidf_(float x) { return 1.f / (1.f + expf(-x)); }

__global__ void k_prep(const float* lq1, const float* lk1, const float* lq2, const float* lk2, const float* lbl, float* misc, float* rope) {
    int gid = blockIdx.x * blockDim.x + threadIdx.x;
    if (gid == 0) {
        float s1 = 0.f, s2 = 0.f;
        for (int i = 0; i < 64; ++i) { s1 += lq1[i] * lk1[i]; s2 += lq2[i] * lk2[i]; }
        misc[0] = expf(s1) - expf(s2) + LAM_INIT;
    }
    if (gid < 512) {
        float a = lbl[gid], b = lbl[512 + gid], m = fmaxf(a, b);
        float ea = expf(a - m), eb = expf(b - m);
        misc[64 + gid] = ea / (ea + eb);
    }
    if (gid < 8196 * 32) {
        int pos = gid / 32, i = gid % 32;
        float inv = powf(10000.0f, -(float)i * 2.0f / 64.0f);
        float ang = (float)pos * inv;
        rope[(size_t)gid * 2] = (float)cos((double)ang);
        rope[(size_t)gid * 2 + 1] = (float)sin((double)ang);
    }
}

template <bool TB>
__global__ void __launch_bounds__(256) k_sgemm(const float* __restrict__ A, int lda, const float* __restrict__ B, int ldb, float* __restrict__ C, int ldc, int M, int N, int K, int causal) {
    __shared__ float As[8][128 + 4];
    __shared__ float Bs[8][128 + 4];
    const int tid = threadIdx.x, tx = tid % 16, ty = tid / 16;
    const int m0 = blockIdx.y * 128, n0 = blockIdx.x * 128;
    if (causal == 1 && n0 > m0 + 127) return;
    int Kend = K; if (causal == 2) Kend = (m0 + 128 < K) ? m0 + 128 : K;
    float acc[8][8];
#pragma unroll
    for (int i = 0; i < 8; ++i)
#pragma unroll
        for (int j = 0; j < 8; ++j) acc[i][j] = 0.f;
    const int ar = tid / 2, ak = (tid % 2) * 4;
    for (int k0 = 0; k0 < Kend; k0 += 8) {
        {
            float4 v = *(const float4*)(A + (size_t)(m0 + ar) * lda + k0 + ak);
            As[ak + 0][ar] = v.x; As[ak + 1][ar] = v.y; As[ak + 2][ar] = v.z; As[ak + 3][ar] = v.w;
        }
        if (TB) {
            float4 v = *(const float4*)(B + (size_t)(n0 + ar) * ldb + k0 + ak);
            Bs[ak + 0][ar] = v.x; Bs[ak + 1][ar] = v.y; Bs[ak + 2][ar] = v.z; Bs[ak + 3][ar] = v.w;
        } else {
            const int bk = tid / 32, bn = (tid % 32) * 4;
            float4 v = *(const float4*)(B + (size_t)(k0 + bk) * ldb + n0 + bn);
            Bs[bk][bn + 0] = v.x; Bs[bk][bn + 1] = v.y; Bs[bk][bn + 2] = v.z; Bs[bk][bn + 3] = v.w;
        }
        __syncthreads();
#pragma unroll
        for (int k = 0; k < 8; ++k) {
            float a[8], b[8];
#pragma unroll
            for (int i = 0; i < 8; ++i) a[i] = As[k][ty * 8 + i];
#pragma unroll
            for (int j = 0; j < 8; ++j) b[j] = Bs[k][tx * 8 + j];
#pragma unroll
            for (int i = 0; i < 8; ++i)
#pragma unroll
                for (int j = 0; j < 8; ++j) acc[i][j] += a[i] * b[j];
        }
        __syncthreads();
    }
#pragma unroll
    for (int i = 0; i < 8; ++i) {
        float* cp = C + (size_t)(m0 + ty * 8 + i) * ldc + n0 + tx * 8;
        *(float4*)cp = make_float4(acc[i][0], acc[i][1], acc[i][2], acc[i][3]);
        *(float4*)(cp + 4) = make_float4(acc[i][4], acc[i][5], acc[i][6], acc[i][7]);
    }
}
static void sgemm(hipStream_t st, bool tb, const float* A, int lda, const float* B, int ldb, float* C, int ldc, int M, int N, int K, int causal = 0) {
    dim3 g(N / 128, M / 128);
    if (tb) k_sgemm<true><<<g, 256, 0, st>>>(A, lda, B, ldb, C, ldc, M, N, K, causal);
    else k_sgemm<false><<<g, 256, 0, st>>>(A, lda, B, ldb, C, ldc, M, N, K, causal);
}

__device__ __forceinline__ int row_pos(int row) { return row < MP ? (row % SEQ) : PAST + ((row - MP) % DS); }
__global__ void k_post_in(const float* __restrict__ proj, const float* __restrict__ misc, const float* __restrict__ rope,
                          float* QR, float* KR, float* F, float* KB, float* out) {
    const int row = blockIdx.x, c = threadIdx.x;
    const float* pr = proj + (size_t)row * INC;
    const int pos = row_pos(row);
    const int d = c % 64, i = d % 32;
    const float cs = rope[((size_t)pos * 32 + i) * 2], sn = rope[((size_t)pos * 32 + i) * 2 + 1];
    const int base = c - d;
    float q, k;
    if (d < 32) { q = pr[C_QA + c] * cs - pr[C_QA + base + d + 32] * sn; k = pr[C_KA + c] * cs - pr[C_KA + base + d + 32] * sn; }
    else        { q = pr[C_QA + c] * cs + pr[C_QA + base + d - 32] * sn; k = pr[C_KA + c] * cs + pr[C_KA + base + d - 32] * sn; }
    QR[(size_t)row * 512 + c] = q; KR[(size_t)row * 512 + c] = k;
    const float v = pr[C_VA + c];
    if (row < MP) { out[O_KP + (size_t)row * 512 + c] = k; out[O_VP + (size_t)row * 512 + c] = v; }
    else { out[O_KS + (size_t)(row - MP) * 512 + c] = k; out[O_VS + (size_t)(row - MP) * 512 + c] = v; }
    const float lb = misc[64 + c], fr = pr[C_FB + c];
    F[(size_t)row * 512 + c] = lb + (1.f - lb) * sigmoidf_(fr);
    KB[(size_t)row * 512 + c] = (1.f - lb) * sigmoidf_(-fr);
}

__global__ void __launch_bounds__(256) k_softmax_comb(float* S1, const float* S2, const float* misc) {
    const int q = blockIdx.x, tid = threadIdx.x, n = q + 1;
    float* s1 = S1 + (size_t)q * SEQ; const float* s2 = S2 + (size_t)q * SEQ;
    const float lam = misc[0];
    __shared__ float red[4][256];
    float m1 = -INFINITY, m2 = -INFINITY;
    for (int k = tid; k < n; k += 256) { m1 = fmaxf(m1, s1[k]); m2 = fmaxf(m2, s2[k]); }
    red[0][tid] = m1; red[1][tid] = m2; __syncthreads();
    for (int s = 128; s > 0; s >>= 1) { if (tid < s) { red[0][tid] = fmaxf(red[0][tid], red[0][tid + s]); red[1][tid] = fmaxf(red[1][tid], red[1][tid + s]); } __syncthreads(); }
    m1 = red[0][0]; m2 = red[1][0]; __syncthreads();
    float l1 = 0.f, l2 = 0.f;
    for (int k = tid; k < n; k += 256) { l1 += expf((s1[k] - m1) * 0.125f); l2 += expf((s2[k] - m2) * 0.125f); }
    red[2][tid] = l1; red[3][tid] = l2; __syncthreads();
    for (int s = 128; s > 0; s >>= 1) { if (tid < s) { red[2][tid] += red[2][tid + s]; red[3][tid] += red[3][tid + s]; } __syncthreads(); }
    l1 = 1.f / red[2][0]; l2 = lam / red[3][0];
    const int nfill = ((q / 128) + 1) * 128;
    for (int k = tid; k < nfill; k += 256) {
        float a = 0.f;
        if (k < n) a = expf((s1[k] - m1) * 0.125f) * l1 - expf((s2[k] - m2) * 0.125f) * l2;
        s1[k] = a;
    }
}

__global__ void __launch_bounds__(256) k_dec_scores(const float* __restrict__ QR, const float* __restrict__ KR, const float* __restrict__ ck, const int* __restrict__ pt, float* SS) {
    const int bh = blockIdx.y, b = bh / NH, h = bh % NH, tid = threadIdx.x;
    __shared__ float qs[DS][128];
    for (int i = tid; i < DS * 128; i += 256) qs[i / 128][i % 128] = QR[(size_t)(MP + b * DS + i / 128) * 512 + h * 128 + i % 128];
    __syncthreads();
    const int key = blockIdx.x * 256 + tid;
    if (key >= PAST + DS) return;
    const float* kp;
    if (key < PAST) { const int pg = pt[b * NPG + key / PAGE]; kp = ck + ((size_t)pg * PAGE + key % PAGE) * 512 + h * 128; }
    else kp = KR + (size_t)(MP + b * DS + (key - PAST)) * 512 + h * 128;
    float acc[DS][2];
#pragma unroll
    for (int t = 0; t < DS; ++t) { acc[t][0] = 0.f; acc[t][1] = 0.f; }
    for (int d = 0; d < 64; d += 4) {
        const float4 k1 = *(const float4*)(kp + d), k2 = *(const float4*)(kp + 64 + d);
#pragma unroll
        for (int t = 0; t < DS; ++t) {
            acc[t][0] += qs[t][d] * k1.x + qs[t][d + 1] * k1.y + qs[t][d + 2] * k1.z + qs[t][d + 3] * k1.w;
            acc[t][1] += qs[t][64 + d] * k2.x + qs[t][64 + d + 1] * k2.y + qs[t][64 + d + 2] * k2.z + qs[t][64 + d + 3] * k2.w;
        }
    }
#pragma unroll
    for (int t = 0; t < DS; ++t)
#pragma unroll
        for (int m = 0; m < 2; ++m) SS[(((size_t)bh * 2 + m) * DS + t) * 8196 + key] = acc[t][m] * 0.125f;
}
__global__ void __launch_bounds__(256) k_dec_softmax(float* SS, const float* misc) {
    const int bh = blockIdx.x / DS, t = blockIdx.x % DS, tid = threadIdx.x, n = PAST + t + 1;
    float* s1 = SS + (((size_t)bh * 2 + 0) * DS + t) * 8196; const float* s2 = SS + (((size_t)bh * 2 + 1) * DS + t) * 8196;
    const float lam = misc[0];
    __shared__ float red[4][256];
    float m1 = -INFINITY, m2 = -INFINITY;
    for (int k = tid; k < n; k += 256) { m1 = fmaxf(m1, s1[k]); m2 = fmaxf(m2, s2[k]); }
    red[0][tid] = m1; red[1][tid] = m2; __syncthreads();
    for (int s = 128; s > 0; s >>= 1) { if (tid < s) { red[0][tid] = fmaxf(red[0][tid], red[0][tid + s]); red[1][tid] = fmaxf(red[1][tid], red[1][tid + s]); } __syncthreads(); }
    m1 = red[0][0]; m2 = red[1][0]; __syncthreads();
    float l1 = 0.f, l2 = 0.f;
    for (int k = tid; k < n; k += 256) { l1 += expf(s1[k] - m1); l2 += expf(s2[k] - m2); }
    red[2][tid] = l1; red[3][tid] = l2; __syncthreads();
    for (int s = 128; s > 0; s >>= 1) { if (tid < s) { red[2][tid] += red[2][tid + s]; red[3][tid] += red[3][tid + s]; } __syncthreads(); }
    l1 = 1.f / red[2][0]; l2 = lam / red[3][0];
    for (int k = tid; k < PAST + DS; k += 256) {
        float a = 0.f;
        if (k < n) a = expf(s1[k] - m1) * l1 - expf(s2[k] - m2) * l2;
        s1[k] = a;
    }
}
__global__ void __launch_bounds__(1024) k_dec_pv(const float* __restrict__ SS, const float* __restrict__ proj, const float* __restrict__ cv, const int* __restrict__ pt, float* OA) {
    const int bh = blockIdx.x, b = bh / NH, h = bh % NH, e = threadIdx.x % 128, g = threadIdx.x / 128;
    float o[DS] = {0.f, 0.f, 0.f, 0.f};
    const float* a0 = SS + (((size_t)bh * 2 + 0) * DS) * 8196;
    for (int key = g; key < PAST + DS; key += 8) {
        float v;
        if (key < PAST) { const int pg = pt[b * NPG + key / PAGE]; v = cv[((size_t)pg * PAGE + key % PAGE) * 512 + h * 128 + e]; }
        else v = proj[(size_t)(MP + b * DS + (key - PAST)) * INC + C_VA + h * 128 + e];
#pragma unroll
        for (int t = 0; t < DS; ++t) o[t] += a0[(size_t)t * 8196 + key] * v;
    }
    __shared__ float red[8][DS][128];
#pragma unroll
    for (int t = 0; t < DS; ++t) red[g][t][e] = o[t];
    __syncthreads();
    if (g < DS) { float s = 0.f; for (int j = 0; j < 8; ++j) s += red[j][g][e]; OA[(size_t)(MP + b * DS + g) * 512 + h * 128 + e] = s; }
}

__global__ void __launch_bounds__(128) k_hgrn(const float* __restrict__ proj, const float* __restrict__ F, const float* __restrict__ KB, const float* __restrict__ s0, float* OB, float* out) {
    const int blk = blockIdx.x, j = threadIdx.x;
    int row0, T, h; const float* sin_ = nullptr; float* sout;
    if (blk < NB * NH) { const int b = blk / NH; h = blk % NH; row0 = b * SEQ; T = SEQ; sout = out + O_HP + (size_t)blk * 128 * 128; }
    else { const int r = blk - NB * NH, b = r / NH; h = r % NH; row0 = MP + b * DS; T = DS; sin_ = s0 + (size_t)r * 128 * 128; sout = out + O_HS + (size_t)r * 128 * 128; }
    float S[128];
#pragma unroll
    for (int i = 0; i < 128; ++i) S[i] = sin_ ? sin_[i * 128 + j] : 0.f;
    constexpr int TS = 8;
    __shared__ float sq[TS][128], sk[TS][128], sf[TS][128];
    for (int t0 = 0; t0 < T; t0 += TS) {
        const int nt = (T - t0 < TS) ? T - t0 : TS;
        __syncthreads();
        for (int tt = 0; tt < nt; ++tt) {
            const size_t r = (size_t)(row0 + t0 + tt);
            sq[tt][j] = proj[r * INC + C_QB + h * 128 + j]; sk[tt][j] = KB[r * 512 + h * 128 + j]; sf[tt][j] = F[r * 512 + h * 128 + j];
        }
        __syncthreads();
        for (int tt = 0; tt < nt; ++tt) {
            const size_t r = (size_t)(row0 + t0 + tt);
            const float v = proj[r * INC + C_IB + h * 128 + j];
            float o = 0.f;
#pragma unroll
            for (int i = 0; i < 128; ++i) { S[i] = sf[tt][i] * S[i] + sk[tt][i] * v; o += S[i] * sq[tt][i]; }
            OB[r * 512 + h * 128 + j] = o;
        }
    }
#pragma unroll
    for (int i = 0; i < 128; ++i) sout[i * 128 + j] = S[i];
}

__global__ void __launch_bounds__(512) k_post_mix(float* OA, float* OB, const float* __restrict__ proj, const float* __restrict__ sg, const float* __restrict__ hg) {
    const int row = blockIdx.x, c = threadIdx.x, w = c / 64, lane = c % 64;
    float a = OA[(size_t)row * 512 + c], b = OB[(size_t)row * 512 + c];
    float sa = a * a, sb = b * b;
    for (int o = 32; o > 0; o >>= 1) { sa += __shfl_xor(sa, o); sb += __shfl_xor(sb, o); }
    __shared__ float ra[8], rb[8];
    if (lane == 0) { ra[w] = sa; rb[w] = sb; }
    __syncthreads();
    const int hh = c / 128;
    sa = ra[2 * hh] + ra[2 * hh + 1]; sb = rb[2 * hh] + rb[2 * hh + 1];
    const int e = c % 128;
    a = a * rsqrtf(sa * (1.f / 128.f) + RMS_EPS) * sg[e] * (1.f - LAM_INIT);
    const float gbv = proj[(size_t)row * INC + C_GB + c];
    b = b * rsqrtf(sb * (1.f / 128.f) + RMS_EPS) * hg[e] * (gbv * sigmoidf_(gbv));
    OA[(size_t)row * 512 + c] = a; OB[(size_t)row * 512 + c] = b;
}
__global__ void __launch_bounds__(256) k_merge(const float* __restrict__ TA, const float* __restrict__ TB, const float* __restrict__ proj, float* MG) {
    const int row = blockIdx.x;
    for (int c = threadIdx.x; c < DM; c += 256) {
        const float ga = proj[(size_t)row * INC + C_GA + c], gg = proj[(size_t)row * INC + C_GG + c];
        MG[(size_t)row * DM + c] = sigmoidf_(ga) * TA[(size_t)row * DM + c] + sigmoidf_(gg) * TB[(size_t)row * DM + c];
    }
}
__global__ void __launch_bounds__(256) k_ln(const float* __restrict__ res, const float* __restrict__ pre, const float* __restrict__ g, const float* __restrict__ bb, float* out) {
    const int row = blockIdx.x, tid = threadIdx.x;
    float v[4]; float s = 0.f;
#pragma unroll
    for (int i = 0; i < 4; ++i) { const int c = tid + 256 * i; v[i] = ALPHA * res[(size_t)row * DM + c] + pre[(size_t)row * DM + c]; s += v[i]; }
    __shared__ float red[256];
    red[tid] = s; __syncthreads();
    for (int st = 128; st > 0; st >>= 1) { if (tid < st) red[tid] += red[tid + st]; __syncthreads(); }
    const float mean = red[0] * (1.f / DM); __syncthreads();
    float q = 0.f;
#pragma unroll
    for (int i = 0; i < 4; ++i) { v[i] -= mean; q += v[i] * v[i]; }
    red[tid] = q; __syncthreads();
    for (int st = 128; st > 0; st >>= 1) { if (tid < st) red[tid] += red[tid + st]; __syncthreads(); }
    const float rstd = rsqrtf(red[0] * (1.f / DM) + LN_EPS);
#pragma unroll
    for (int i = 0; i < 4; ++i) { const int c = tid + 256 * i; out[(size_t)row * DM + c] = v[i] * rstd * g[c] + bb[c]; }
}
__global__ void __launch_bounds__(256) k_conv_gelu(const float* __restrict__ UP, const float* __restrict__ sc, const float* __restrict__ cw, const float* __restrict__ cb, float* U, float* out) {
    const int row = blockIdx.x;
    int t, T; const float* c0 = nullptr; float* cs;
    if (row < MP) { t = row % SEQ; T = SEQ; cs = out + O_CP + (size_t)(row / SEQ) * 2 * DFF; }
    else { const int r = row - MP; t = r % DS; T = DS; c0 = sc + (size_t)(r / DS) * 2 * DFF; cs = out + O_CS + (size_t)(r / DS) * 2 * DFF; }
    for (int j = threadIdx.x; j < DFF; j += 256) {
        const float a0 = UP[(size_t)row * INC + j];
        float a1, a2;
        if (t >= 1) a1 = UP[(size_t)(row - 1) * INC + j]; else a1 = c0 ? c0[DFF + j] : 0.f;
        if (t >= 2) a2 = UP[(size_t)(row - 2) * INC + j]; else a2 = c0 ? c0[(size_t)t * DFF + j] : 0.f;
        const float c = cb[j] + cw[j] * a2 + cw[DFF + j] * a1 + cw[2 * DFF + j] * a0;
        const float ge = 0.5f * c * (1.f + erff(c * 0.70710678118654752f));
        U[(size_t)row * DFF + j] = ge * UP[(size_t)row * INC + DFF + j];
        if (t >= T - 2) cs[(size_t)(t - (T - 2)) * DFF + j] = a0;
    }
}

extern "C" void kernel_launch(void* const* d_in, const int* in_sizes, int n_in, void* d_out, int out_size, void* d_ws, size_t ws_size, hipStream_t stream) {
    if (n_in != 26 || (size_t)out_size != O_END || ws_size < W_END * 4) { fprintf(stderr, "kernel_launch: unexpected sizes n_in %d out %d ws %zu (need %zu)\n", n_in, out_size, ws_size, W_END * 4); return; }
    const float* xp = (const float*)d_in[0]; const float* xs = (const float*)d_in[1];
    const float* ck = (const float*)d_in[2]; const float* cv = (const float*)d_in[3];
    const float* sh = (const float*)d_in[4]; const float* sc = (const float*)d_in[5]; const int* pt = (const int*)d_in[6];
    const float* w_in = (const float*)d_in[7];
    const float* sg = (const float*)d_in[12]; const float* lbl = (const float*)d_in[13]; const float* hg = (const float*)d_in[14];
    const float* wa = (const float*)d_in[15]; const float* wb = (const float*)d_in[16]; const float* wo = (const float*)d_in[17];
    const float* l1g = (const float*)d_in[18]; const float* l1b = (const float*)d_in[19]; const float* wup = (const float*)d_in[20];
    const float* cw = (const float*)d_in[21]; const float* cb = (const float*)d_in[22]; const float* wdn = (const float*)d_in[23];
    const float* l2g = (const float*)d_in[24]; const float* l2b = (const float*)d_in[25];
    float* out = (float*)d_out; float* ws = (float*)d_ws;
    float *misc = ws + W_MISC, *rope = ws + W_ROPE, *PROJ = ws + W_PROJ, *QR = ws + W_QR, *KR = ws + W_KR, *F = ws + W_F, *KB = ws + W_KB, *OA = ws + W_OA, *OB = ws + W_OB,
          *TA = ws + W_TA, *TB = ws + W_TB, *MG = ws + W_MG, *HPRE = ws + W_HPRE, *H = ws + W_H, *U = ws + W_U, *Y = ws + W_Y, *SC = ws + W_SC, *SS = ws + W_SS;

    k_prep<<<(8196 * 32 + 255) / 256, 256, 0, stream>>>((const float*)d_in[8], (const float*)d_in[9], (const float*)d_in[10], (const float*)d_in[11], lbl, misc, rope);
    sgemm(stream, false, xp, DM, w_in, INC, PROJ, INC, MP, INC, DM);
    sgemm(stream, false, xs, DM, w_in, INC, PROJ + (size_t)MP * INC, INC, MS, INC, DM);
    k_post_in<<<MT, 512, 0, stream>>>(PROJ, misc, rope, QR, KR, F, KB, out);
    for (int bh = 0; bh < NB * NH; ++bh) {
        const int b = bh / NH, h = bh % NH;
        for (int m = 0; m < 2; ++m)
            sgemm(stream, true, QR + (size_t)b * SEQ * 512 + h * 128 + m * 64, 512, KR + (size_t)b * SEQ * 512 + h * 128 + m * 64, 512, SC + (size_t)m * SEQ * SEQ, SEQ, SEQ, SEQ, 64, 1);
        k_softmax_comb<<<SEQ, 256, 0, stream>>>(SC, SC + (size_t)SEQ * SEQ, misc);
        sgemm(stream, false, SC, SEQ, PROJ + (size_t)b * SEQ * INC + C_VA + h * 128, INC, OA + (size_t)b * SEQ * 512 + h * 128, 512, SEQ, 128, SEQ, 2);
    }
    k_dec_scores<<<dim3((PAST + DS + 255) / 256, DB * NH), 256, 0, stream>>>(QR, KR, ck, pt, SS);
    k_dec_softmax<<<DB * NH * DS, 256, 0, stream>>>(SS, misc);
    k_dec_pv<<<DB * NH, 1024, 0, stream>>>(SS, PROJ, cv, pt, OA);
    k_hgrn<<<NB * NH + DB * NH, 128, 0, stream>>>(PROJ, F, KB, sh, OB, out);
    k_post_mix<<<MT, 512, 0, stream>>>(OA, OB, PROJ, sg, hg);
    sgemm(stream, false, OA, 512, wa, DM, TA, DM, MT, DM, 512);
    sgemm(stream, false, OB, 512, wb, DM, TB, DM, MT, DM, 512);
    k_merge<<<MT, 256, 0, stream>>>(TA, TB, PROJ, MG);
    sgemm(stream, false, MG, DM, wo, DM, HPRE, DM, MT, DM, DM);
    k_ln<<<MP, 256, 0, stream>>>(xp, HPRE, l1g, l1b, H);
    k_ln<<<MS, 256, 0, stream>>>(xs, HPRE + (size_t)MP * DM, l1g, l1b, H + (size_t)MP * DM);
    float* UP = PROJ;
    sgemm(stream, false, H, DM, wup, INC, UP, INC, MT, INC, DM);
    k_conv_gelu<<<MT, 256, 0, stream>>>(UP, sc, cw, cb, U, out);
    sgemm(stream, false, U, DFF, wdn, DM, Y, DM, MT, DM, DFF);
    k_ln<<<MP, 256, 0, stream>>>(H, Y, l2g, l2b, out + O_YP);
    k_ln<<<MS, 256, 0, stream>>>(H + (size_t)MP * DM, Y + (size_t)MP * DM, l2g, l2b, out + O_YS);
}
```

```cpp
#include <hip/hip_runtime.h>
#include <math.h>
#include <stdio.h>
#include <stdint.h>

constexpr int DM = 1024, NB = 2, SEQ = 8192, MP = NB * SEQ, DB = 32, DS = 4, MS = DB * DS, MT = MP + MS;
constexpr int PAST = 8192, PAGE = 128, NPG = PAST / PAGE;
constexpr int INC = 5632, DFF = 2816, NH = 4;
constexpr int C_QA = 0, C_KA = 512, C_VA = 1024, C_QB = 1536, C_FB = 2048, C_IB = 2560, C_GB = 3072, C_GA = 3584, C_GG = 4608;
constexpr float ALPHA = 1.189207115002721f;
constexpr float LN_EPS = 1e-5f, RMS_EPS = 1e-5f;
constexpr float LAM_INIT = 0.2f;

constexpr size_t O_YP = 0, O_YS = O_YP + (size_t)MP * DM, O_KP = O_YS + (size_t)MS * DM, O_VP = O_KP + (size_t)MP * 512,
                 O_HP = O_VP + (size_t)MP * 512, O_CP = O_HP + (size_t)NB * NH * 128 * 128, O_KS = O_CP + (size_t)NB * 2 * DFF,
                 O_VS = O_KS + (size_t)MS * 512, O_HS = O_VS + (size_t)MS * 512, O_CS = O_HS + (size_t)DB * NH * 128 * 128,
                 O_END = O_CS + (size_t)DB * 2 * DFF;

__device__ __forceinline__ float sigmoidf_(float x) { return 1.f / (1.f + expf(-x)); }
#include <hip/hip_runtime.h>
#include <cstdio>
#include <cstdint>
namespace pg8 {
#define PG8_LAS __attribute__((address_space(3)))
typedef unsigned short bf16_t;
typedef short bf16x8 __attribute__((ext_vector_type(8)));
typedef float f32x4 __attribute__((ext_vector_type(4)));
typedef unsigned u32x4 __attribute__((ext_vector_type(4)));
constexpr int BM = 256, BK = 64, HALF = 128, HTB = HALF * BK * 2  , STAGE_BYTES = 8 * HTB, NXCD = 8, WGM = 8;

__host__ __device__ __forceinline__ int lds_byte(int r, int c) { const int st = (r >> 4) * 2 + (c >> 5), rr = r & 15, cc = c & 31, ob = rr * 64 + cc * 2; return st * 1024 + (ob ^ (((ob >> 9) & 1) << 5)); }
__host__ __device__ __forceinline__ void stage_rc(int b, int& R, int& C) { const int st = b / 1024, sb = b % 1024, swz = sb ^ (((sb >> 9) & 1) << 5); R = (st >> 1) * 16 + swz / 64; C = (st & 1) * 32 + (swz % 64) / 2; }
__host__ __device__ __forceinline__ int perm32(int rho) { const int n = rho >> 4, i = rho & 15; return 8 * (i >> 2) + 4 * n + (i & 3); }

struct Unit { int pm, pn; };
struct Gemm { const bf16_t* A; const bf16_t* Bt; int M, N, K; };

struct StaticOrder {
    int nM, nN, nwg, G, c;
    __host__ __device__ void init(int M, int N, int G_, int c_) { nM = M / BM; nN = N / BM; nwg = nM * nN; G = G_; c = c_; }
    __host__ __device__ bool next(int i, Unit& u) const {
        const long L = (long)i * G + c; if (L >= nwg) return false;
        int wgid = (int)L; { const int q = nwg / NXCD, r = nwg % NXCD, xcd = wgid % NXCD, off = wgid / NXCD; wgid = (xcd < r ? xcd * (q + 1) : r * (q + 1) + (xcd - r) * q) + off; }
        const int nig = WGM * nN, gid = wgid / nig, fm = gid * WGM, gsz = (nM - fm) < WGM ? (nM - fm) : WGM;
        u.pm = fm + ((wgid % nig) % gsz); u.pn = (wgid % nig) / gsz; return true;
    }
    __device__ __forceinline__ void a_ready(const Unit&) const {}
    __device__ __forceinline__ void done(const Unit&) const {}
};

__device__ __forceinline__ unsigned cvt_pk_bf16(float lo, float hi) { unsigned r; asm volatile("v_cvt_pk_bf16_f32 %0, %1, %2" : "=v"(r) : "v"(lo), "v"(hi)); return r; }
typedef float f32x2 __attribute__((ext_vector_type(2)));
__device__ __forceinline__ f32x2 gelu_pk(f32x2 v) {
    const f32x2 av = __builtin_elementwise_abs(v), d = av * 0.2316418882f + 1.0f;
    f32x2 t; t.x = __builtin_amdgcn_rcpf(d.x); t.y = __builtin_amdgcn_rcpf(d.y);
    f32x2 q = t * 0.5307027145f + (-0.7265760135f); q = q * t + 0.7107068705f; q = q * t + (-0.142248368f); q = q * t + 0.127414796f; q = q * t;
    const f32x2 s = (v * v) * (-0.72134752044f);
    f32x2 e; e.x = __builtin_amdgcn_exp2f(s.x); e.y = __builtin_amdgcn_exp2f(s.y);
    const f32x2 m = v * (q * e), r = v - m;
    f32x2 o; o.x = v.x < 0.f ? m.x : r.x; o.y = v.y < 0.f ? m.y : r.y; return o;
}

template <int ACT  > struct EpiBf16 {
    static constexpr bool PERM = true, AFTER_DRAIN = false; static_assert(ACT == 0 || ACT == 1, "EpiBf16: ACT is 0 (none) or 1 (gelu_pk)");
    bf16_t* O; int ldc; const float* bias; int split_cols; size_t split_stride; float scale0;
    __device__ __forceinline__ void operator()(const f32x4 (&acc)[2][2][4][2], const Unit& u, int wr, int wc, int fr, int fq) const {
        const int row0 = u.pm * BM + wr * 64 + fr; int colt = u.pn * BM; bf16_t* base = O;
        float sc = 1.f; if (split_cols) { const int t = colt / split_cols; base += (size_t)t * split_stride; colt -= t * split_cols; if (t == 0) sc = scale0; }
        const int col0 = colt + wc * 32 + 8 * fq, bcol0 = u.pn * BM + wc * 32 + 8 * fq;
        f32x4 bv[2][2];
#pragma unroll
        for (int bj = 0; bj < 2; ++bj)
#pragma unroll
            for (int n = 0; n < 2; ++n) bv[bj][n] = bias ? *(const f32x4*)(bias + bcol0 + bj * HALF + 4 * n) : (f32x4){0.f, 0.f, 0.f, 0.f};
#pragma unroll
        for (int ai = 0; ai < 2; ++ai)
#pragma unroll
            for (int m = 0; m < 4; ++m) { bf16_t* rowp = base + (size_t)(row0 + ai * HALF + m * 16) * ldc + col0;
#pragma unroll
                for (int bj = 0; bj < 2; ++bj) { f32x4 v0 = acc[ai][bj][m][0] + bv[bj][0], v1 = acc[ai][bj][m][1] + bv[bj][1];
                    if (ACT == 1) { f32x2 a = gelu_pk((f32x2){v0[0], v0[1]}), b = gelu_pk((f32x2){v0[2], v0[3]}), c = gelu_pk((f32x2){v1[0], v1[1]}), d = gelu_pk((f32x2){v1[2], v1[3]});
                        v0 = (f32x4){a.x, a.y, b.x, b.y}; v1 = (f32x4){c.x, c.y, d.x, d.y}; }
                    v0 = v0 * sc; v1 = v1 * sc; u32x4 w; w.x = cvt_pk_bf16(v0[0], v0[1]); w.y = cvt_pk_bf16(v0[2], v0[3]); w.z = cvt_pk_bf16(v1[0], v1[1]); w.w = cvt_pk_bf16(v1[2], v1[3]);
                    *(u32x4*)(rowp + bj * HALF) = w; } }
    }
};

struct PanelStats {
    unsigned* xbuf;
    unsigned* cnt;
    unsigned* tmo;
    int ntn; float eps;
    unsigned code;
    __device__ __forceinline__ bool run(const f32x4 (&v)[2][2][4][2], const Unit& u, int wr, int wc, int fr, int fq, PG8_LAS unsigned char* lds, int wid, int lane) const {
        typedef float f32x2v __attribute__((ext_vector_type(2)));
        PG8_LAS f32x2v* P = (PG8_LAS f32x2v*)lds;
        PG8_LAS f32x2v* S = (PG8_LAS f32x2v*)(lds + 8192);
        PG8_LAS unsigned* flag = (PG8_LAS unsigned*)(lds + 8192 + 2048);
#pragma unroll
        for (int ai = 0; ai < 2; ++ai)
#pragma unroll
            for (int m = 0; m < 4; ++m) {
                float s = 0.f;
#pragma unroll
                for (int bj = 0; bj < 2; ++bj)
#pragma unroll
                    for (int n = 0; n < 2; ++n) { const f32x4 x = v[ai][bj][m][n]; s += (x[0] + x[1]) + (x[2] + x[3]); }
                s += __shfl_xor(s, 16); s += __shfl_xor(s, 32);
                const float mw = s * (1.0f / 64.0f); float q = 0.f;
#pragma unroll
                for (int bj = 0; bj < 2; ++bj)
#pragma unroll
                    for (int n = 0; n < 2; ++n) { const f32x4 d = v[ai][bj][m][n] - mw; q += (d[0] * d[0] + d[1] * d[1]) + (d[2] * d[2] + d[3] * d[3]); }
                q += __shfl_xor(q, 16); q += __shfl_xor(q, 32);
                if (fq == 0) P[(ai * HALF + wr * 64 + m * 16 + fr) * 4 + wc] = (f32x2v){mw, q};
            }
        asm volatile("s_waitcnt lgkmcnt(0)" ::: "memory"); __builtin_amdgcn_s_barrier(); asm volatile("" ::: "memory");
#if defined(BROKEN_EXCHANGE_NO_WAIT)
#warning BROKEN CONTROL BUILD: the row-statistics exchange does not wait; results are wrong by design
        if (blockIdx.x >= 64) { const long long t0_ = clock64(); while (clock64() - t0_ < 60000) __builtin_amdgcn_s_sleep(8); }
#endif
        const int row = wid * 32 + (lane & 31);
        if (lane < 32) {
            const f32x2v a = P[row * 4 + 0], b = P[row * 4 + 1], c = P[row * 4 + 2], d = P[row * 4 + 3];
            const float mt = (a.x + b.x + c.x + d.x) * 0.25f;
            const float da = a.x - mt, db = b.x - mt, dc = c.x - mt, dd = d.x - mt;
            const float m2 = (a.y + b.y) + (c.y + d.y) + 64.0f * ((da * da + db * db) + (dc * dc + dd * dd));
            unsigned long long* slot = (unsigned long long*)xbuf + ((size_t)(u.pm * BM + row) * 4 + u.pn);
            __hip_atomic_store(slot, ((unsigned long long)__float_as_uint(m2) << 32) | __float_as_uint(mt), __ATOMIC_RELAXED, __HIP_MEMORY_SCOPE_AGENT);
        }
        asm volatile("s_waitcnt vmcnt(0)" ::: "memory");
        if (lane == 0) __hip_atomic_fetch_add(cnt + 64 * u.pm, 1u, __ATOMIC_RELAXED, __HIP_MEMORY_SCOPE_AGENT);
        if (wid == 0) {
            bool dead = false; const unsigned long long t0 = __builtin_amdgcn_s_memrealtime(); const unsigned want = 8u * (unsigned)ntn;
            for (;;) {
#if defined(BROKEN_EXCHANGE_NO_WAIT)
                break;
#endif
                if ((unsigned)__builtin_amdgcn_readfirstlane(__hip_atomic_load(cnt + 64 * u.pm, __ATOMIC_RELAXED, __HIP_MEMORY_SCOPE_AGENT)) >= want) break;
                if (__builtin_amdgcn_s_memrealtime() - t0 > 2000000ull) {
                    if (lane == 0) { unsigned expect = 0u; __hip_atomic_compare_exchange_strong(tmo + 1, &expect, code | (unsigned)(u.pm & 0xff), __ATOMIC_RELAXED, __ATOMIC_RELAXED, __HIP_MEMORY_SCOPE_AGENT);
                                     __hip_atomic_store(tmo, 1u, __ATOMIC_RELAXED, __HIP_MEMORY_SCOPE_AGENT); }
                    dead = true; break; }
                __builtin_amdgcn_s_sleep(2);
            }
            __builtin_amdgcn_fence(__ATOMIC_ACQUIRE, "agent");
            if (lane == 0) flag[0] = dead ? 1u : 0u;
        }
        asm volatile("s_waitcnt vmcnt(0) lgkmcnt(0)" ::: "memory"); __builtin_amdgcn_s_barrier(); asm volatile("" ::: "memory");
        const bool bad = flag[0] != 0u;
        if (lane < 32) {
            const unsigned long long* slot = (const unsigned long long*)xbuf + (size_t)(u.pm * BM + row) * 4; float mt[4], m2[4]; float ms = 0.f;
#pragma unroll
            for (int t = 0; t < 4; ++t) { if (t < ntn) { const unsigned long long w = __hip_atomic_load(slot + t, __ATOMIC_RELAXED, __HIP_MEMORY_SCOPE_AGENT); mt[t] = __uint_as_float((unsigned)w); m2[t] = __uint_as_float((unsigned)(w >> 32)); } else { mt[t] = 0.f; m2[t] = 0.f; } ms += mt[t]; }
            const float mean = ms / (float)ntn; float q = 0.f;
#pragma unroll
            for (int t = 0; t < 4; ++t) if (t < ntn) { const float dm = mt[t] - mean; q += m2[t] + 256.0f * dm * dm; }
            S[row] = (f32x2v){mean, 1.0f / sqrtf(q / (256.0f * (float)ntn) + eps)};
        }
        asm volatile("s_waitcnt lgkmcnt(0)" ::: "memory"); __builtin_amdgcn_s_barrier(); asm volatile("" ::: "memory");
        return bad;
    }
};
struct EpiLnRes {
    static constexpr bool PERM = false, AFTER_DRAIN = true;
    const float* base; float* out; int ldc; const float* bias; PanelStats st; unsigned poison;
    __device__ __forceinline__ void fused(f32x4 (&acc)[2][2][4][2], const Unit& u, int wr, int wc, int fr, int fq, PG8_LAS unsigned char* lds, int wid, int lane) const {
        typedef float f32x2v __attribute__((ext_vector_type(2)));
        const PG8_LAS f32x2v* S = (const PG8_LAS f32x2v*)(lds + 8192);
        const int col0 = u.pn * BM + wc * 32 + 4 * fq;
#pragma unroll
        for (int bj = 0; bj < 2; ++bj)
#pragma unroll
            for (int n = 0; n < 2; ++n) { const f32x4 bv = bias ? *(const f32x4*)(bias + col0 + bj * HALF + n * 16) : (f32x4){0.f, 0.f, 0.f, 0.f};
#pragma unroll
                for (int ai = 0; ai < 2; ++ai)
#pragma unroll
                    for (int m = 0; m < 4; ++m) acc[ai][bj][m][n] += bv; }
        f32x4 pre[4][2][2];
#pragma unroll
        for (int m = 0; m < 4; ++m) { const size_t off = (size_t)(u.pm * BM + wr * 64 + m * 16 + fr) * ldc + col0;
#pragma unroll
            for (int bj = 0; bj < 2; ++bj)
#pragma unroll
                for (int n = 0; n < 2; ++n) pre[m][bj][n] = *(const f32x4*)(base + off + bj * HALF + n * 16); }
        const bool bad = st.run(acc, u, wr, wc, fr, fq, lds, wid, lane) || poison != 0u;
        const float qnan = __builtin_nanf("");
#pragma unroll
        for (int ai = 0; ai < 2; ++ai)
#pragma unroll
            for (int m = 0; m < 4; ++m) { const int r = ai * HALF + wr * 64 + m * 16 + fr; const f32x2v sr = S[r]; const size_t off = (size_t)(u.pm * BM + r) * ldc + col0;
#pragma unroll
                for (int bj = 0; bj < 2; ++bj)
#pragma unroll
                    for (int n = 0; n < 2; ++n) { const f32x4 bs = ai == 0 ? pre[m][bj][n] : *(const f32x4*)(base + off + bj * HALF + n * 16); f32x4 o = bs + (acc[ai][bj][m][n] - sr.x) * sr.y;
                        if (bad) o = (f32x4){qnan, qnan, qnan, qnan}; *(f32x4*)(out + off + bj * HALF + n * 16) = o; }
                if (m & 1) asm volatile("" ::: "memory"); }
    }
};
struct EpiLnResLn {
    static constexpr bool PERM = false, AFTER_DRAIN = true;
    const float* base; float* out; bf16_t* xn; int ldc; const float* bias; PanelStats st1, st2; unsigned poison;
    __device__ __forceinline__ void fused(f32x4 (&acc)[2][2][4][2], const Unit& u, int wr, int wc, int fr, int fq, PG8_LAS unsigned char* lds, int wid, int lane) const {
        typedef float f32x2v __attribute__((ext_vector_type(2))); typedef unsigned u32x2v __attribute__((ext_vector_type(2)));
        const PG8_LAS f32x2v* S = (const PG8_LAS f32x2v*)(lds + 8192);
        const int col0 = u.pn * BM + wc * 32 + 4 * fq;
#pragma unroll
        for (int bj = 0; bj < 2; ++bj)
#pragma unroll
            for (int n = 0; n < 2; ++n) { const f32x4 bv = bias ? *(const f32x4*)(bias + col0 + bj * HALF + n * 16) : (f32x4){0.f, 0.f, 0.f, 0.f};
#pragma unroll
                for (int ai = 0; ai < 2; ++ai)
#pragma unroll
                    for (int m = 0; m < 4; ++m) acc[ai][bj][m][n] += bv; }
        bool bad = st1.run(acc, u, wr, wc, fr, fq, lds, wid, lane) || poison != 0u;
        const float qnan = __builtin_nanf("");
#pragma unroll
        for (int ai = 0; ai < 2; ++ai)
#pragma unroll
            for (int m = 0; m < 4; ++m) { const int r = ai * HALF + wr * 64 + m * 16 + fr; const f32x2v sr = S[r]; const size_t off = (size_t)(u.pm * BM + r) * ldc + col0;
#pragma unroll
                for (int bj = 0; bj < 2; ++bj)
#pragma unroll
                    for (int n = 0; n < 2; ++n) { const f32x4 bs = *(const f32x4*)(base + off + bj * HALF + n * 16); acc[ai][bj][m][n] = bs + (acc[ai][bj][m][n] - sr.x) * sr.y; }
                asm volatile("" : "+v"(acc[ai][0][m][0]), "+v"(acc[ai][0][m][1]), "+v"(acc[ai][1][m][0]), "+v"(acc[ai][1][m][1]));
                if (m & 1) asm volatile("" ::: "memory"); }
        const bool bad1 = bad;
        bad = st2.run(acc, u, wr, wc, fr, fq, lds, wid, lane) || bad;
#pragma unroll
        for (int ai = 0; ai < 2; ++ai)
#pragma unroll
            for (int m = 0; m < 4; ++m) { const int r = ai * HALF + wr * 64 + m * 16 + fr; const f32x2v sr = S[r]; const size_t off = (size_t)(u.pm * BM + r) * ldc + col0;
#pragma unroll
                for (int bj = 0; bj < 2; ++bj)
#pragma unroll
                    for (int n = 0; n < 2; ++n) { const f32x4 x1 = acc[ai][bj][m][n]; *(f32x4*)(out + off + bj * HALF + n * 16) = bad1 ? (f32x4){qnan, qnan, qnan, qnan} : x1;
                        const f32x4 o = (x1 - sr.x) * sr.y; u32x2v w; w.x = cvt_pk_bf16(o[0], o[1]); w.y = cvt_pk_bf16(o[2], o[3]);
                        if (bad) { w.x = 0x7fc07fc0u; w.y = 0x7fc07fc0u; } *(u32x2v*)(xn + off + bj * HALF + n * 16) = w; }
                asm volatile("" ::: "memory"); }
    }
};

template <class Epi, class Sched, bool ALIGN_EPI = false, bool SP2 = false>
__device__ __forceinline__ void gemm_phase(PG8_LAS unsigned char* lds, const Gemm g, const Sched& S, const Epi& E) {
    const int tid = threadIdx.x, wid = __builtin_amdgcn_readfirstlane(tid >> 6), lane = tid & 63, wr = wid >> 2, wc = wid & 3, fr = lane & 15, fq = lane >> 4;
    const int K = g.K, nt = K / BK;
    unsigned voffA[2], voffB[2];
#pragma unroll
    for (int i = 0; i < 2; ++i) { int R, C; stage_rc(tid * 16 + i * 8192, R, C); const int Rb = Epi::PERM ? ((R & ~31) + perm32(R & 31)) : R;
        voffA[i] = (unsigned)(R * K + C) * 2u; voffB[i] = (unsigned)(Rb * K + C) * 2u; }
    const size_t kstep = (size_t)(BK * 2);
    const size_t hstep = (size_t)HALF * K * 2;
    const size_t tstep = 2 * hstep;
    const unsigned ldsw = (unsigned)wid * 1024u;
    const int aoff = lds_byte(wr * 64 + fr, fq * 8), boff = lds_byte(wc * 32 + fr, fq * 8);
#define PG8_SA(b, h) (((b) * 2 + (h)) * HTB)
#define PG8_SB(b, h) ((4 + (b) * 2 + (h)) * HTB)
#define PG8_STAGE(bufoff, gbase, voff) do { _Pragma("unroll") for (int _i = 0; _i < 2; ++_i) \
        __builtin_amdgcn_global_load_lds((const unsigned*)((const char*)(gbase) + (voff)[_i]), (PG8_LAS unsigned*)(lds + (bufoff) + ldsw + _i * 8192), 16, 0, 0); } while (0)
#define PG8_LDA(dst, b, h) do { _Pragma("unroll") for (int m = 0; m < 4; ++m) _Pragma("unroll") for (int k = 0; k < 2; ++k) dst[m][k] = *(const PG8_LAS bf16x8*)(lds + PG8_SA(b, h) + aoff + m * 2048 + k * 1024); } while (0)
#define PG8_LDB(dst, b, h) do { _Pragma("unroll") for (int n = 0; n < 2; ++n) _Pragma("unroll") for (int k = 0; k < 2; ++k) dst[n][k] = *(const PG8_LAS bf16x8*)(lds + PG8_SB(b, h) + boff + n * 2048 + k * 1024); } while (0)
#define PG8_MMA(ai, bj, At, Bt) do { __builtin_amdgcn_s_setprio(1); _Pragma("unroll") for (int m = 0; m < 4; ++m) _Pragma("unroll") for (int n = 0; n < 2; ++n) _Pragma("unroll") for (int k = 0; k < 2; ++k) \
        acc[ai][bj][m][n] = __builtin_amdgcn_mfma_f32_16x16x32_bf16(Bt[n][k], At[m][k], acc[ai][bj][m][n], 0, 0, 0); __builtin_amdgcn_s_setprio(0); } while (0)
#define PG8_WAIT_V(n) asm volatile("s_waitcnt vmcnt(" #n ")" ::: "memory")
#define PG8_WAIT_L(n) asm volatile("s_waitcnt lgkmcnt(" #n ")" ::: "memory")
#define PG8_BAR __builtin_amdgcn_s_barrier()
#define PG8_SCHED __builtin_amdgcn_sched_barrier(0)
    Unit cur, nxt; int ui = 0;
    if (!S.next(0, cur)) return;
    f32x4 acc[2][2][4][2];
#pragma unroll
    for (int a = 0; a < 2; ++a)
#pragma unroll
        for (int b = 0; b < 2; ++b)
#pragma unroll
            for (int m = 0; m < 4; ++m)
#pragma unroll
                for (int n = 0; n < 2; ++n) acc[a][b][m][n] = (f32x4){0.f, 0.f, 0.f, 0.f};
    bf16x8 At[4][2], B0[2][2], B1[2][2];
    const char* cA = (const char*)g.A + (size_t)cur.pm * tstep; const char* cB = (const char*)g.Bt + (size_t)cur.pn * tstep;
    S.a_ready(cur);
    if constexpr (SP2) {
        PG8_STAGE(PG8_SB(0, 0), cB, voffB); PG8_STAGE(PG8_SB(0, 1), cB + hstep, voffB); PG8_STAGE(PG8_SA(0, 0), cA, voffA); PG8_STAGE(PG8_SA(0, 1), cA + hstep, voffA);
        if (wr == 1) PG8_BAR;
        PG8_WAIT_V(2); PG8_BAR;
        PG8_STAGE(PG8_SB(1, 0), cB + kstep, voffB); PG8_STAGE(PG8_SA(1, 0), cA + kstep, voffA); PG8_STAGE(PG8_SB(1, 1), cB + hstep + kstep, voffB);
        PG8_WAIT_V(6); PG8_BAR;
    } else {
        PG8_STAGE(PG8_SB(0, 0), cB, voffB); PG8_STAGE(PG8_SA(0, 0), cA, voffA); PG8_STAGE(PG8_SB(0, 1), cB + hstep, voffB); PG8_STAGE(PG8_SA(0, 1), cA + hstep, voffA);
        if (wr == 1) PG8_BAR;
        PG8_WAIT_V(4); PG8_BAR;
        PG8_STAGE(PG8_SB(1, 0), cB + kstep, voffB); PG8_STAGE(PG8_SA(1, 0), cA + kstep, voffA); PG8_STAGE(PG8_SB(1, 1), cB + hstep + kstep, voffB);
        PG8_WAIT_V(6); PG8_BAR;
    }
    for (;;) {
        const bool has_next = S.next(ui + 1, nxt);
        const char* nA = has_next ? (const char*)g.A + (size_t)nxt.pm * tstep : cA; const char* nB = has_next ? (const char*)g.Bt + (size_t)nxt.pn * tstep : cB;
        for (int t = 0; t < nt; t += 2) {
            const bool last = (t == nt - 2);
            const char* a1 = cA + (size_t)(t + 1) * kstep;
            const char* a2 = last ? nA : cA + (size_t)(t + 2) * kstep; const char* b2 = last ? nB : cB + (size_t)(t + 2) * kstep;
            const char* a3 = a2 + kstep; const char* b3 = b2 + kstep;
            if (last && has_next) S.a_ready(nxt);
            if constexpr (SP2) {
            PG8_LDB(B0, 0, 0); PG8_LDB(B1, 0, 1); PG8_SCHED; PG8_LDA(At, 0, 0); PG8_STAGE(PG8_SA(1, 1), a1 + hstep, voffA);
            PG8_WAIT_V(8); PG8_WAIT_L(0); PG8_BAR; PG8_MMA(0, 0, At, B0); PG8_MMA(0, 1, At, B1); PG8_BAR; PG8_SCHED;
            PG8_LDA(At, 0, 1); PG8_STAGE(PG8_SB(0, 0), b2, voffB); PG8_STAGE(PG8_SB(0, 1), b2 + hstep, voffB); PG8_STAGE(PG8_SA(0, 0), a2, voffA);
            PG8_WAIT_V(8); PG8_WAIT_L(0); PG8_BAR; PG8_MMA(1, 0, At, B0); PG8_MMA(1, 1, At, B1); PG8_BAR; PG8_SCHED;
            PG8_LDB(B0, 1, 0); PG8_LDB(B1, 1, 1); PG8_SCHED; PG8_LDA(At, 1, 0); PG8_STAGE(PG8_SA(0, 1), a2 + hstep, voffA);
            PG8_WAIT_V(8); PG8_WAIT_L(0); PG8_BAR; PG8_MMA(0, 0, At, B0); PG8_MMA(0, 1, At, B1); PG8_BAR; PG8_SCHED;
            PG8_LDA(At, 1, 1); PG8_STAGE(PG8_SB(1, 0), b3, voffB); PG8_STAGE(PG8_SB(1, 1), b3 + hstep, voffB); PG8_STAGE(PG8_SA(1, 0), a3, voffA);
            PG8_WAIT_V(8); PG8_WAIT_L(0); PG8_BAR; PG8_MMA(1, 0, At, B0); PG8_MMA(1, 1, At, B1); PG8_BAR; PG8_SCHED;
            } else {
            PG8_LDB(B0, 0, 0); PG8_SCHED; PG8_LDA(At, 0, 0); PG8_STAGE(PG8_SA(1, 1), a1 + hstep, voffA);
            PG8_WAIT_L(8); PG8_BAR; PG8_WAIT_L(0); PG8_MMA(0, 0, At, B0); PG8_BAR; PG8_SCHED;
            PG8_LDB(B1, 0, 1); PG8_STAGE(PG8_SB(0, 0), b2, voffB);
            PG8_BAR; PG8_WAIT_L(0); PG8_MMA(0, 1, At, B1); PG8_BAR;
            PG8_LDA(At, 0, 1); PG8_STAGE(PG8_SA(0, 0), a2, voffA);
            PG8_BAR; PG8_WAIT_L(0); PG8_MMA(1, 0, At, B0); PG8_BAR; PG8_SCHED;
            PG8_STAGE(PG8_SB(0, 1), b2 + hstep, voffB);
            PG8_WAIT_V(6); PG8_BAR; PG8_MMA(1, 1, At, B1); PG8_BAR;
            PG8_LDB(B0, 1, 0); PG8_SCHED; PG8_LDA(At, 1, 0); PG8_STAGE(PG8_SA(0, 1), a2 + hstep, voffA);
            PG8_WAIT_L(8); PG8_BAR; PG8_WAIT_L(0); PG8_MMA(0, 0, At, B0); PG8_BAR; PG8_SCHED;
            PG8_LDB(B1, 1, 1); PG8_STAGE(PG8_SB(1, 0), b3, voffB);
            PG8_BAR; PG8_WAIT_L(0); PG8_MMA(0, 1, At, B1); PG8_BAR;
            PG8_LDA(At, 1, 1); PG8_STAGE(PG8_SA(1, 0), a3, voffA);
            PG8_BAR; PG8_WAIT_L(0); PG8_MMA(1, 0, At, B0); PG8_BAR; PG8_SCHED;
            PG8_STAGE(PG8_SB(1, 1), b3 + hstep, voffB);
            PG8_WAIT_V(6); PG8_BAR; PG8_MMA(1, 1, At, B1); PG8_BAR;
            }
        }
        if constexpr (ALIGN_EPI) { if (wr == 0) PG8_BAR; }
        if constexpr (!Epi::AFTER_DRAIN) { E(acc, cur, wr, wc, fr, fq); S.done(cur); }
        if (!has_next) break;
#pragma unroll
        for (int a = 0; a < 2; ++a)
#pragma unroll
            for (int b = 0; b < 2; ++b)
#pragma unroll
                for (int m = 0; m < 4; ++m)
#pragma unroll
                    for (int n = 0; n < 2; ++n) acc[a][b][m][n] = (f32x4){0.f, 0.f, 0.f, 0.f};
        cur = nxt; cA = nA; cB = nB; ++ui;
        if constexpr (ALIGN_EPI) { if (wr == 1) PG8_BAR; }
    }
    PG8_WAIT_V(0);
    if constexpr (!ALIGN_EPI) { if (wr == 0) PG8_BAR; }
    PG8_BAR;
    if constexpr (Epi::AFTER_DRAIN) { E.fused(acc, cur, wr, wc, fr, fq, lds, wid, lane); S.done(cur); }
#undef PG8_SA
#undef PG8_SB
#undef PG8_STAGE
#undef PG8_LDA
#undef PG8_LDB
#undef PG8_MMA
#undef PG8_WAIT_V
#undef PG8_WAIT_L
#undef PG8_BAR
#undef PG8_SCHED
}
}
#define GAS __attribute__((address_space(1)))
#define LAS __attribute__((address_space(3)))
typedef unsigned short bf16;
typedef unsigned v4u __attribute__((ext_vector_type(4)));
typedef float f32x4 __attribute__((ext_vector_type(4)));
typedef short bf16x8 __attribute__((ext_vector_type(8)));
typedef GAS unsigned gu32;
typedef GAS unsigned long long gu64;
#define RLX_AGENT __ATOMIC_RELAXED, __HIP_MEMORY_SCOPE_AGENT
#define LDS_WAIT() asm volatile("s_waitcnt lgkmcnt(0)" ::: "memory")
#define VM_WAIT() asm volatile("s_waitcnt vmcnt(0)" ::: "memory")
__device__ __forceinline__ unsigned long long rt() { return __builtin_amdgcn_s_memrealtime(); }
__device__ __forceinline__ unsigned f2bf(float f) { unsigned u = __builtin_bit_cast(unsigned, f); return (u + 0x7fffu + ((u >> 16) & 1u)) >> 16; }
__device__ __forceinline__ unsigned pk2(float lo, float hi) { return f2bf(lo) | (f2bf(hi) << 16); }

#define XB_TMO      128
#define XB_XCNT(j)  (256  + 64 * (j))
#define XB_XSUB(j)  (1280 + 64 * (j))
#define XB_XGEN(j)  (2304 + 64 * (j))
#define XB_TOP      3328
#define XB_TOPGEN   3392
#define XCD_BAR_WORDS 3456
#define XB_SPIN_CAP (1u << 18)

__device__ __forceinline__ unsigned xb_ld(unsigned* p)              { return __hip_atomic_load(p, __ATOMIC_RELAXED, __HIP_MEMORY_SCOPE_AGENT); }
__device__ __forceinline__ unsigned xb_add(unsigned* p, unsigned v) { return __hip_atomic_fetch_add(p, v, __ATOMIC_RELAXED, __HIP_MEMORY_SCOPE_AGENT); }
__device__ __forceinline__ unsigned xb_xcc_id() { return (unsigned)__builtin_amdgcn_s_getreg((3 << 11) | 20) & 0xFu; }
#define XB_SPIN(cond, bar) do { unsigned _sp = 0; while (cond) { __builtin_amdgcn_s_sleep(1); \
    if ((++_sp & 255u) == 0u) { if (xb_ld(&(bar)[XB_TMO])) break; if (_sp > XB_SPIN_CAP) { atomicAdd(&(bar)[XB_TMO], 1u); break; } } } } while (0)

struct XcdBarrier {
    unsigned* bar; unsigned x;
    volatile LAS unsigned* st;
};

__device__ __forceinline__ XcdBarrier xcd_barrier_post(unsigned* bar, volatile LAS unsigned* st) {
    XcdBarrier b; b.bar = bar; b.x = xb_xcc_id(); b.st = st;
    if (threadIdx.x == 0) (void)xb_add(&bar[XB_XCNT(b.x)], 1u);
    return b;
}
__device__ __forceinline__ void xcd_barrier_complete(unsigned* bar, unsigned x, unsigned& nloc, unsigned& nx) {
    const unsigned G = gridDim.x * gridDim.y * gridDim.z;
    unsigned sum, cnt, mine, sp = 0u;
    for (;;) {
        sum = 0u; cnt = 0u; mine = 0u;
#pragma unroll
        for (unsigned j = 0; j < 16; ++j) { const unsigned c = xb_ld(&bar[XB_XCNT(j)]); sum += c; cnt += (c > 0u) ? 1u : 0u; mine = (j == x) ? c : mine; }
        if (sum == G) break;
        __builtin_amdgcn_s_sleep(1);
        if ((++sp & 255u) == 0u) { if (xb_ld(&bar[XB_TMO])) break; if (sp > XB_SPIN_CAP) { atomicAdd(&bar[XB_TMO], 1u); break; } }
    }
    nloc = mine > 0u ? mine : 1u; nx = cnt > 0u ? cnt : 1u;
}

__device__ __forceinline__ void xcd_barrier(const XcdBarrier& b) {
    asm volatile("s_waitcnt vmcnt(0)" ::: "memory");
    __syncthreads();
    if (threadIdx.x == 0) {
        unsigned* bar = b.bar;
        __builtin_amdgcn_s_waitcnt(0);
        unsigned nloc = b.st[0], nx = b.st[1];
        if (nloc == 0u) { xcd_barrier_complete(bar, b.x, nloc, nx); b.st[0] = nloc; b.st[1] = nx; }
        const unsigned old = xb_add(&bar[XB_XSUB(b.x)], 1u);
        const unsigned gen = old / nloc;
        if (old + 1u == (gen + 1u) * nloc) {
            __builtin_amdgcn_fence(__ATOMIC_RELEASE, "agent");
            asm volatile("s_waitcnt vmcnt(0)" ::: "memory");
            const unsigned og = xb_add(&bar[XB_TOP], 1u);
            const unsigned tg = og / nx;
            if (og + 1u == (tg + 1u) * nx) xb_add(&bar[XB_TOPGEN], 1u);
            else XB_SPIN(xb_ld(&bar[XB_TOPGEN]) == tg, bar);
            __builtin_amdgcn_fence(__ATOMIC_ACQUIRE, "agent");
            xb_add(&bar[XB_XGEN(b.x)], 1u);
            asm volatile("s_waitcnt vmcnt(0)" ::: "memory");
        } else {
            XB_SPIN(xb_ld(&bar[XB_XGEN(b.x)]) == gen, bar);
            __builtin_amdgcn_fence(__ATOMIC_ACQUIRE, "agent");
            asm volatile("s_waitcnt vmcnt(0)" ::: "memory");
        }
    }
    __syncthreads();
}

namespace at2 {
typedef short bf16x8 __attribute__((ext_vector_type(8)));
typedef short s16x4 __attribute__((ext_vector_type(4)));
typedef float f32x16 __attribute__((ext_vector_type(16)));
typedef float f32x4 __attribute__((ext_vector_type(4)));
typedef unsigned u32x4 __attribute__((ext_vector_type(4)));
typedef unsigned short bf16;
constexpr int NW = 8, QBLK = 32, KVBLK = 64, QB = NW * QBLK, DQ = 64, DV = 128;
constexpr int SHM_V = KVBLK * DV * 2, SHM_K = KVBLK * DQ * 2;
constexpr int LDS_BYTES = 2 * SHM_V + 2 * SHM_K + NW * 64 * 4;
constexpr float THR = 8.f;
#define A2_KSWZ(row, colB) ((row) * 128 + ((colB) ^ (((row) & 7) << 4)))
#define A2_SBAR() __builtin_amdgcn_sched_barrier(0)
__device__ __forceinline__ int v_st(int k, int c) { const int kk = (k & ~0xC) | ((k & 4) << 1) | ((k & 8) >> 1); return ((kk >> 3) * 4 + (c >> 5)) * 512 + ((kk & 7) * 32 + (c & 31)) * 2; }
__device__ __forceinline__ int v_rd_base(int lane) { return ((lane & 3) << 3) | (((lane >> 2) & 3) << 6) | (((lane >> 4) & 1) << 5) | (((lane >> 5) & 1) << 8); }
constexpr int v_rd_off(int d0, int ks, int half) { return d0 * 512 + ks * 4096 + half * 2048; }
__device__ __forceinline__ int crow(int r, int hi) { return (r & 3) + 8 * (r >> 2) + 4 * hi; }
__device__ __forceinline__ unsigned cvtpk(float lo, float hi) { unsigned r; asm volatile("v_cvt_pk_bf16_f32 %0, %1, %2" : "=v"(r) : "v"(lo), "v"(hi)); return r; }
__device__ __forceinline__ void mask_tile(f32x16& p0, f32x16& p1, int dq) {
    const float NEG = -__builtin_inff();
#pragma unroll
    for (int r = 0; r < 16; ++r) {
        const int c = (r & 3) + 8 * (r >> 2);
        if (dq - c < 0) p0[r] = NEG;
        if (dq - c - 32 < 0) p1[r] = NEG;
    }
}
__device__ __forceinline__ void partialSM(f32x16& p0, f32x16& p1, float& m_reg, float& mn, float& alpha) {
    float pmax = p0[0];
#pragma unroll
    for (int r = 1; r < 16; ++r) pmax = fmaxf(pmax, p0[r]);
#pragma unroll
    for (int r = 0; r < 16; ++r) pmax = fmaxf(pmax, p1[r]);
    { auto rr = __builtin_amdgcn_permlane32_swap(__float_as_uint(pmax), __float_as_uint(pmax), false, false);
      pmax = fmaxf(__uint_as_float(rr[0]), __uint_as_float(rr[1])); }
    if (__builtin_expect(__all((pmax - m_reg) <= THR), 1)) { mn = m_reg; alpha = 1.f; }
    else { mn = fmaxf(m_reg, pmax); alpha = __builtin_amdgcn_exp2f(m_reg - mn); m_reg = mn; }
#pragma unroll
    for (int r = 0; r < 16; ++r) p0[r] = p0[r] - mn;
#pragma unroll
    for (int r = 0; r < 16; ++r) p1[r] = p1[r] - mn;
#pragma unroll
    for (int r = 0; r < 16; ++r) p0[r] = __builtin_amdgcn_exp2f(p0[r]);
}
__device__ __forceinline__ void finishSM(f32x16& p0, f32x16& p1, float alpha, float& l_reg, bf16x8& pa0, bf16x8& pa1, bf16x8& pa2, bf16x8& pa3) {
#pragma unroll
    for (int r = 0; r < 16; ++r) p1[r] = __builtin_amdgcn_exp2f(p1[r]);
    float ps = 0;
#pragma unroll
    for (int r = 0; r < 16; ++r) ps += p0[r];
#pragma unroll
    for (int r = 0; r < 16; ++r) ps += p1[r];
    { auto rr = __builtin_amdgcn_permlane32_swap(__float_as_uint(ps), __float_as_uint(ps), false, false);
      ps = __uint_as_float(rr[0]) + __uint_as_float(rr[1]); }
    l_reg = l_reg * alpha + ps;
#define A2_PK4(P, B_, OUT) do { unsigned a0 = cvtpk(P[B_+0], P[B_+1]), a1 = cvtpk(P[B_+2], P[B_+3]);                          \
        unsigned b0 = cvtpk(P[B_+4], P[B_+5]), b1 = cvtpk(P[B_+6], P[B_+7]);                                             \
        auto r0 = __builtin_amdgcn_permlane32_swap(a0, b0, false, false); auto r1 = __builtin_amdgcn_permlane32_swap(a1, b1, false, false); \
        u32x4 w = {r0[0], r1[0], r0[1], r1[1]}; OUT = *reinterpret_cast<bf16x8*>(&w); } while (0)
    A2_PK4(p0, 0, pa0); A2_PK4(p0, 8, pa1); A2_PK4(p1, 0, pa2); A2_PK4(p1, 8, pa3);
#undef A2_PK4
}
template <int KB>
__device__ __forceinline__ void qkt(f32x16& p0, f32x16& p1, const char* K_lds, int r32, int hi, const bf16x8* qr) {
    p0 = f32x16{}; p1 = f32x16{};
#pragma unroll
    for (int d0 = 0; d0 < 4; ++d0) { const char* a = K_lds + KB * SHM_K + A2_KSWZ(r32, (d0 * 16 + hi * 8) * 2);
        bf16x8 b0 = *reinterpret_cast<const bf16x8*>(a);
        bf16x8 b1 = *reinterpret_cast<const bf16x8*>(a + 32 * 128);
        p0 = __builtin_amdgcn_mfma_f32_32x32x16_bf16(b0, qr[d0], p0, 0, 0, 0);
        p1 = __builtin_amdgcn_mfma_f32_32x32x16_bf16(b1, qr[d0], p1, 0, 0, 0); }
}
template <int VB>
__device__ __forceinline__ void pv_tile(f32x16* o, int vb0, bf16x8 pa0, bf16x8 pa1, bf16x8 pa2, bf16x8 pa3) {
#define A2_TRRD(dst, off) asm volatile("ds_read_b64_tr_b16 %0, %1 offset:%2" : "=&v"(dst) : "v"(vb0), "i"(off) : "memory")
#define A2_PV_D0(d0) do { s16x4 l0, l1, l2, l3, h0, h1, h2, h3; constexpr int b_ = VB * SHM_V + v_rd_off(d0, 0, 0); \
        A2_TRRD(l0, b_); A2_TRRD(h0, b_ + 2048); A2_TRRD(l1, b_ + 4096); A2_TRRD(h1, b_ + 6144); A2_TRRD(l2, b_ + 8192); A2_TRRD(h2, b_ + 10240); A2_TRRD(l3, b_ + 12288); A2_TRRD(h3, b_ + 14336); \
        asm volatile("s_waitcnt lgkmcnt(0)" ::: "memory"); A2_SBAR();   \
        o[d0] = __builtin_amdgcn_mfma_f32_32x32x16_bf16(pa0, (bf16x8){l0[0], l0[1], l0[2], l0[3], h0[0], h0[1], h0[2], h0[3]}, o[d0], 0, 0, 0);   \
        o[d0] = __builtin_amdgcn_mfma_f32_32x32x16_bf16(pa1, (bf16x8){l1[0], l1[1], l1[2], l1[3], h1[0], h1[1], h1[2], h1[3]}, o[d0], 0, 0, 0);   \
        o[d0] = __builtin_amdgcn_mfma_f32_32x32x16_bf16(pa2, (bf16x8){l2[0], l2[1], l2[2], l2[3], h2[0], h2[1], h2[2], h2[3]}, o[d0], 0, 0, 0);   \
        o[d0] = __builtin_amdgcn_mfma_f32_32x32x16_bf16(pa3, (bf16x8){l3[0], l3[1], l3[2], l3[3], h3[0], h3[1], h3[2], h3[3]}, o[d0], 0, 0, 0); } while (0)
    A2_PV_D0(0); A2_PV_D0(1); A2_PV_D0(2); A2_PV_D0(3);
#undef A2_PV_D0
#undef A2_TRRD
}
struct BlockRef { const bf16* Q; const bf16* K; const bf16* V; bf16* O; int P0; };
struct Seam { bf16x8 qr[4]; bf16x8 st_v0, st_v1, st_k0; };
#define A2_VMW() asm volatile("s_waitcnt vmcnt(0)" ::: "memory")
#define A2_VMWN(n) asm volatile("s_waitcnt vmcnt(%0)" :: "i"(n) : "memory")
#define A2_SLOAD(Kp, Vp, k0) do { S.st_v0 = *(const bf16x8*)((Vp) + (size_t)((k0) + sr) * DV + sc); S.st_v1 = *(const bf16x8*)((Vp) + (size_t)((k0) + 32 + sr) * DV + sc); \
                                  S.st_k0 = *(const bf16x8*)((Kp) + (size_t)((k0) + kr) * DQ + kc); } while (0)
#define A2_SWRITE_K(bf) do { *(bf16x8*)(K_lds + (bf) * SHM_K + kws) = S.st_k0; } while (0)
#define A2_SWRITE_V(bf) do { *(bf16x8*)(V_lds + (bf) * SHM_V + vst0) = S.st_v0; *(bf16x8*)(V_lds + (bf) * SHM_V + vst1) = S.st_v1; } while (0)
__device__ __forceinline__ void prime(const BlockRef& cur, char* lds, Seam& S) {
    const int tid = threadIdx.x, wid = __builtin_amdgcn_readfirstlane(tid >> 6), lane = tid & 63, r32 = lane & 31, hi = lane >> 5;
    const int sr = tid >> 4, sc = (tid & 15) * 8, kr = tid >> 3, kc = (tid & 7) * 8, kws = A2_KSWZ(kr, kc * 2); char* K_lds = lds + 2 * SHM_V;
#pragma unroll
    for (int d0 = 0; d0 < 4; ++d0) S.qr[d0] = *(const bf16x8*)(cur.Q + (size_t)(wid * QBLK + r32) * DQ + d0 * 16 + hi * 8);
    A2_SLOAD(cur.K, cur.V, 0); A2_VMW(); A2_SWRITE_K(0);
    __syncthreads();
}
__device__ __forceinline__ void block(const BlockRef& cur, const BlockRef& nxt, char* lds, Seam& S) {
    const int tid = threadIdx.x, wid = __builtin_amdgcn_readfirstlane(tid >> 6), lane = tid & 63, r32 = lane & 31, hi = lane >> 5;
    const int NT = cur.P0 / KVBLK + 4;
    const int qlo = cur.P0 + wid * QBLK, qm = qlo + r32 - 4 * hi;
    char* V_lds = lds; char* K_lds = lds + 2 * SHM_V;
    float* ws = (float*)(lds + 2 * SHM_V + 2 * SHM_K) + wid * 64; float* li_l = ws, * al_l = ws + 32;
    float m_reg = -1e30f, l_reg = 0; f32x16 o[4] = {};
    const int sr = tid >> 4, sc = (tid & 15) * 8, vst0 = v_st(sr, sc), vst1 = v_st(32 + sr, sc), kr = tid >> 3, kc = (tid & 7) * 8, kws = A2_KSWZ(kr, kc * 2);
    const int vb0 = (int)(uintptr_t)V_lds + v_rd_base(lane);
    const bf16* Kh = cur.K; const bf16* Vh = cur.V;
#define A2_RESC(a) do { if (__any((a) < 1.f)) { if (hi == 0) al_l[r32] = (a); asm volatile("s_waitcnt lgkmcnt(0)" ::: "memory");              \
                     _Pragma("unroll") for (int d_ = 0; d_ < 4; ++d_) _Pragma("unroll") for (int r = 0; r < 16; ++r) o[d_][r] *= al_l[crow(r, hi)]; } } while (0)
#define A2_KBASE(t) ((t) * KVBLK)
#define A2_MASKT(P0_, P1_, t) do { const int kb_ = A2_KBASE(t); if (kb_ + KVBLK - 1 > qlo) mask_tile(P0_, P1_, qm - kb_); } while (0)
    f32x16 pA0, pA1, pB0, pB1; float mnA, mnB, alA, alB; bf16x8 pa0, pa1, pa2, pa3;
    A2_SWRITE_V(0); A2_SBAR();
    A2_SLOAD(Kh, Vh, A2_KBASE(1));
    A2_SBAR(); qkt<0>(pA0, pA1, K_lds, r32, hi, S.qr);
    A2_MASKT(pA0, pA1, 0); partialSM(pA0, pA1, m_reg, mnA, alA);
    A2_VMW(); A2_SWRITE_V(1); A2_SWRITE_K(1);
    __syncthreads();
#define A2_HALF_STEP(PX0, PX1, mnX, alX, PY0, PY1, alY, t, KB, VB, SB) do {                                                      \
        A2_SBAR(); qkt<KB>(PX0, PX1, K_lds, r32, hi, S.qr);                                             \
        finishSM(PY0, PY1, alY, l_reg, pa0, pa1, pa2, pa3); A2_SBAR();                                                           \
        if ((t) + 1 < NT) { A2_SLOAD(Kh, Vh, A2_KBASE((t) + 1)); A2_SBAR(); }                                               \
        pv_tile<VB>(o, vb0, pa0, pa1, pa2, pa3); A2_MASKT(PX0, PX1, (t)); partialSM(PX0, PX1, m_reg, mnX, alX);                                        \
        __syncthreads();                                                                                                      \
        if ((t) + 1 < NT) { A2_VMW(); A2_SWRITE_V(SB); A2_SWRITE_K(SB); }                                                                          \
        A2_RESC(alX); __syncthreads(); } while (0)
    for (int t = 1; t + 1 < NT; t += 2) {
        A2_HALF_STEP(pB0, pB1, mnB, alB, pA0, pA1, alA, t, 1, 0, 0);
        A2_HALF_STEP(pA0, pA1, mnA, alA, pB0, pB1, alB, t + 1, 0, 1, 1);
    }
    A2_SBAR(); qkt<1>(pB0, pB1, K_lds, r32, hi, S.qr); A2_SBAR();
    A2_SLOAD(nxt.K, nxt.V, 0); A2_SBAR();
#pragma unroll
    for (int d0 = 0; d0 < 4; ++d0) S.qr[d0] = *(const bf16x8*)(nxt.Q + (size_t)(wid * QBLK + r32) * DQ + d0 * 16 + hi * 8);
    A2_SBAR();
    finishSM(pA0, pA1, alA, l_reg, pa0, pa1, pa2, pa3); A2_SBAR();
    pv_tile<0>(o, vb0, pa0, pa1, pa2, pa3);
    A2_MASKT(pB0, pB1, NT - 1); partialSM(pB0, pB1, m_reg, mnB, alB); __syncthreads(); A2_RESC(alB);
    finishSM(pB0, pB1, alB, l_reg, pa0, pa1, pa2, pa3); A2_SBAR(); pv_tile<1>(o, vb0, pa0, pa1, pa2, pa3);
    A2_SBAR(); A2_VMWN(4); A2_SWRITE_K(0); A2_SBAR();
    if (hi == 0) li_l[r32] = l_reg; asm volatile("s_waitcnt lgkmcnt(0)" ::: "memory");
    float rli[16];
#pragma unroll
    for (int r = 0; r < 16; ++r) rli[r] = __builtin_amdgcn_rcpf(li_l[crow(r, hi)]);
    bf16* Ow = cur.O + (size_t)(wid * QBLK) * DV;
#pragma unroll
    for (int r = 0; r < 16; ++r) { const int orow = crow(r, hi);
#pragma unroll
        for (int d0 = 0; d0 < 4; ++d0) { const float v = o[d0][r] * rli[r];
            const float vn = __shfl_xor(v, 1);
            if ((r32 & 1) == 0) *(unsigned*)(Ow + (size_t)orow * DV + d0 * 32 + r32) = cvtpk(v, vn); } }
    __syncthreads();
#undef A2_RESC
#undef A2_KBASE
#undef A2_MASKT
#undef A2_HALF_STEP
}
#undef A2_VMW
#undef A2_VMWN
#undef A2_SLOAD
#undef A2_SWRITE_K
#undef A2_SWRITE_V
__device__ __forceinline__ BlockRef ref_of(int item, int pass, const bf16* QA, const bf16* KA, const bf16* VA, bf16* O12) {
    const int bhm = item >> 4, p = item & 15, qb = pass ? 31 - p : p;
    BlockRef r; r.Q = QA + ((size_t)bhm * 8192 + (size_t)qb * QB) * DQ; r.K = KA + (size_t)bhm * 8192 * DQ; r.V = VA + (size_t)(bhm >> 1) * 8192 * DV;
    r.O = O12 + ((size_t)bhm * 8192 + (size_t)qb * QB) * DV; r.P0 = qb * QB; return r;
}
__device__ __forceinline__ void attn_phase(char* lds, const bf16* QA, const bf16* KA, const bf16* VA, bf16* O12, int first, int stride) {
    int item = first; if (item >= 256) return;
    int pass = 0;
    BlockRef cur = ref_of(item, 0, QA, KA, VA, O12);
    Seam S;
    prime(cur, lds, S);
    for (;;) {
        const bool more_pass = pass == 0, more_item = item + stride < 256, last = !more_pass && !more_item;
        int itn = item, passn = pass + 1;
        if (!more_pass) { passn = 0; itn = more_item ? item + stride : item; }
        const BlockRef nxt = last ? cur : ref_of(itn, passn, QA, KA, VA, O12);
        block(cur, nxt, lds, S);
        if (last) break;
        cur = nxt; item = itn; pass = passn;
    }
}
#undef A2_KSWZ
#undef A2_SBAR
}
namespace hg {
typedef short h8 __attribute__((ext_vector_type(8)));
typedef float f4 __attribute__((ext_vector_type(4)));
typedef unsigned u4 __attribute__((ext_vector_type(4)));
typedef unsigned short bf16;
#define HG_LAS __attribute__((address_space(3)))
constexpr int P72 = 72, P136 = 136;
__device__ __forceinline__ float bf2f(bf16 u) { return __uint_as_float((unsigned)u << 16); }
__device__ __forceinline__ bf16 f2bf_(float f) { unsigned u = __float_as_uint(f); return (bf16)((u + 0x7fffu + ((u >> 16) & 1u)) >> 16); }
__device__ __forceinline__ h8 lds_h8(HG_LAS const bf16* p) { return *(HG_LAS const h8*)p; }
#define HG_MFMA(a, b, c) __builtin_amdgcn_mfma_f32_16x16x32_bf16((a), (b), (c), 0, 0, 0)

__device__ __forceinline__ void chunk_cumsum(const float* __restrict__ LOGF, int row0, int h, HG_LAS float* segt, float (&lg)[16], float (&bb)[16], float& total, float& bref) {
    const int tid = threadIdx.x, k = tid & 127, seg = tid >> 7;
#pragma unroll
    for (int i = 0; i < 16; ++i) lg[i] = LOGF[(size_t)(row0 + 16 * seg + i) * 512 + h * 128 + k];
    float c = 0.f;
#pragma unroll
    for (int i = 0; i < 16; ++i) { c += lg[i]; bb[i] = c; }
    __syncthreads();
    segt[seg * 128 + k] = c;
    __syncthreads();
    const float t0 = segt[k], t1 = segt[128 + k], t2 = segt[256 + k], t3 = segt[384 + k];
    const float pre = seg == 0 ? 0.f : seg == 1 ? t0 : seg == 2 ? t0 + t1 : t0 + t1 + t2;
    total = (t0 + t1) + (t2 + t3); bref = t0 + t1;
#pragma unroll
    for (int i = 0; i < 16; ++i) bb[i] += pre;
}
__device__ __forceinline__ void load_vt(const bf16* __restrict__ IB, int row0, int h, HG_LAS bf16* Vt) {
    const int tid = threadIdx.x;
#pragma unroll
    for (int j = 0; j < 2; ++j) {
        const int s = (tid >> 4) + 32 * j, v0 = (tid & 15) * 8;
        const h8 x = *(const h8*)(IB + (size_t)(row0 + s) * 512 + h * 128 + v0);
#pragma unroll
        for (int i = 0; i < 8; ++i) Vt[(v0 + i) * P72 + s] = (bf16)x[i];
    }
}
__device__ __forceinline__ void h1_unit(int cu, const float* __restrict__ LOGF, const bf16* __restrict__ IB, float* __restrict__ DST, float* __restrict__ DEC, HG_LAS unsigned char* L) {
    const int tid = threadIdx.x, lane = tid & 63, w = __builtin_amdgcn_readfirstlane(tid >> 6), fr = lane & 15, fq = lane >> 4;
    const int bh = cu >> 7, c = cu & 127, b = bh >> 2, h = bh & 3, row0 = b * 8192 + c * 64;
    HG_LAS bf16* Kt = (HG_LAS bf16*)L;
    HG_LAS bf16* Vt = Kt + 128 * P72;
    HG_LAS float* segt = (HG_LAS float*)(Vt + 128 * P72);
    float lg[16], bb[16], total, bref;
    chunk_cumsum(LOGF, row0, h, segt, lg, bb, total, bref);
    const int k = tid & 127, seg = tid >> 7;
    { u4 w0, w1; unsigned pk[8];
#pragma unroll
      for (int i = 0; i < 8; ++i) {
          const float a0 = (1.f - __expf(lg[2 * i])) * __expf(total - bb[2 * i]), a1 = (1.f - __expf(lg[2 * i + 1])) * __expf(total - bb[2 * i + 1]);
          pk[i] = (unsigned)f2bf_(a0) | ((unsigned)f2bf_(a1) << 16); }
      w0 = (u4){pk[0], pk[1], pk[2], pk[3]}; w1 = (u4){pk[4], pk[5], pk[6], pk[7]};
      *(HG_LAS u4*)(Kt + k * P72 + 16 * seg) = w0; *(HG_LAS u4*)(Kt + k * P72 + 16 * seg + 8) = w1; }
    if (seg == 0) DEC[(size_t)cu * 128 + k] = __expf(total);
    load_vt(IB, row0, h, Vt);
    __syncthreads();
    const h8 a0 = lds_h8(Vt + (16 * w + fr) * P72 + 8 * fq), a1 = lds_h8(Vt + (16 * w + fr) * P72 + 32 + 8 * fq);
    float* dst = DST + (size_t)cu * 16384;
#pragma unroll
    for (int kb = 0; kb < 8; ++kb) {
        const h8 b0 = lds_h8(Kt + (16 * kb + fr) * P72 + 8 * fq), b1 = lds_h8(Kt + (16 * kb + fr) * P72 + 32 + 8 * fq);
        f4 acc = {0.f, 0.f, 0.f, 0.f};
        acc = HG_MFMA(a0, b0, acc); acc = HG_MFMA(a1, b1, acc);
#pragma unroll
        for (int i = 0; i < 4; ++i) dst[(16 * w + 4 * fq + i) * 128 + 16 * kb + fr] = acc[i];
    }
    __syncthreads();
}
__device__ __forceinline__ void h2_scan(int gid, const float* __restrict__ DST, const float* __restrict__ DEC, bf16* __restrict__ SCT, float* __restrict__ out_state) {
    const int bh = gid >> 14, e = gid & 16383, v = e >> 7, k = e & 127;
    float S = 0.f;
    const float* dp = DST + (size_t)bh * 128 * 16384 + e; const float* cp = DEC + (size_t)bh * 128 * 128 + k; bf16* sp = SCT + (size_t)bh * 128 * 16384 + e;
    for (int c0 = 0; c0 < 128; c0 += 8) {
        float d[8], g[8];
#pragma unroll
        for (int j = 0; j < 8; ++j) { d[j] = dp[(size_t)(c0 + j) * 16384]; g[j] = cp[(c0 + j) * 128]; }
#pragma unroll
        for (int j = 0; j < 8; ++j) { sp[(size_t)(c0 + j) * 16384] = f2bf_(S); S = g[j] * S + d[j]; }
    }
    out_state[(size_t)bh * 16384 + k * 128 + v] = S;
}
__device__ __forceinline__ void h3_unit(int cu, const float* __restrict__ LOGF, const bf16* __restrict__ QB, const bf16* __restrict__ IB, const bf16* __restrict__ SGB, const bf16* __restrict__ SCT,
                                        const float* __restrict__ hgn, bf16* __restrict__ OBF, HG_LAS unsigned char* L) {
    const int tid = threadIdx.x, lane = tid & 63, w = __builtin_amdgcn_readfirstlane(tid >> 6), fr = lane & 15, fq = lane >> 4;
    const int bh = cu >> 7, c = cu & 127, b = bh >> 2, h = bh & 3, row0 = b * 8192 + c * 64;
    HG_LAS bf16* Q1 = (HG_LAS bf16*)L;
    HG_LAS bf16* Q2 = Q1 + 64 * P136;
    HG_LAS bf16* K2 = Q2 + 64 * P136;
    HG_LAS bf16* Vt = K2 + 64 * P136;
    HG_LAS bf16* St = Vt + 128 * P72;
    HG_LAS bf16* AT = St + 128 * P136;
    HG_LAS float* segt = (HG_LAS float*)(AT + 64 * P72);
    HG_LAS float* rsq = segt + 512;
    float lg[16], bb[16], total, bref;
    chunk_cumsum(LOGF, row0, h, segt, lg, bb, total, bref);
    const int k = tid & 127, seg = tid >> 7;
#pragma unroll
    for (int i = 0; i < 16; ++i) {
        const int t = 16 * seg + i;
        const float q = bf2f(QB[(size_t)(row0 + t) * 512 + h * 128 + k]);
        const float kk = 1.f - __expf(lg[i]);
        Q1[t * P136 + k] = f2bf_(q * __expf(bb[i]));
        Q2[t * P136 + k] = f2bf_(q * __expf(bb[i] - bref));
        K2[t * P136 + k] = f2bf_(kk * __expf(bref - bb[i]));
    }
    load_vt(IB, row0, h, Vt);
    { const bf16* sp = SCT + (size_t)cu * 16384;
#pragma unroll
      for (int j = 0; j < 4; ++j) { const int id = tid + 512 * j, v = id >> 4, k0 = (id & 15) * 8;
          *(HG_LAS u4*)(St + v * P136 + k0) = *(const u4*)(sp + v * 128 + k0); } }
    __syncthreads();
    { const int tb = w >> 1;
      h8 a[4];
#pragma unroll
      for (int ks = 0; ks < 4; ++ks) a[ks] = lds_h8(Q2 + (16 * tb + fr) * P136 + 32 * ks + 8 * fq);
#pragma unroll
      for (int j = 0; j < 2; ++j) { const int sb = (w & 1) * 2 + j;
          f4 acc = {0.f, 0.f, 0.f, 0.f};
          if (sb <= tb) {
#pragma unroll
              for (int ks = 0; ks < 4; ++ks) acc = HG_MFMA(a[ks], lds_h8(K2 + (16 * sb + fr) * P136 + 32 * ks + 8 * fq), acc);
          }
#pragma unroll
          for (int i = 0; i < 4; ++i) { const int t = 16 * tb + 4 * fq + i, s = 16 * sb + fr; AT[t * P72 + s] = (sb <= tb && s <= t) ? f2bf_(acc[i]) : (bf16)0; }
      } }
    __syncthreads();
    const int tb = w & 3, vh = w >> 2;
    f4 o[4];
    { h8 a[4], p[2];
#pragma unroll
      for (int ks = 0; ks < 4; ++ks) a[ks] = lds_h8(Q1 + (16 * tb + fr) * P136 + 32 * ks + 8 * fq);
#pragma unroll
      for (int ks = 0; ks < 2; ++ks) p[ks] = lds_h8(AT + (16 * tb + fr) * P72 + 32 * ks + 8 * fq);
#pragma unroll
      for (int j = 0; j < 4; ++j) { const int vb = vh * 4 + j;
          f4 acc = {0.f, 0.f, 0.f, 0.f};
#pragma unroll
          for (int ks = 0; ks < 4; ++ks) acc = HG_MFMA(a[ks], lds_h8(St + (16 * vb + fr) * P136 + 32 * ks + 8 * fq), acc);
#pragma unroll
          for (int ks = 0; ks < 2; ++ks) acc = HG_MFMA(p[ks], lds_h8(Vt + (16 * vb + fr) * P72 + 32 * ks + 8 * fq), acc);
          o[j] = acc; } }
    float ss[4];
#pragma unroll
    for (int i = 0; i < 4; ++i) { float s = 0.f;
#pragma unroll
        for (int j = 0; j < 4; ++j) s += o[j][i] * o[j][i];
        s += __shfl_xor(s, 1); s += __shfl_xor(s, 2); s += __shfl_xor(s, 4); s += __shfl_xor(s, 8);
        ss[i] = s; }
    if (fr == 0) {
#pragma unroll
        for (int i = 0; i < 4; ++i) rsq[vh * 64 + 16 * tb + 4 * fq + i] = ss[i]; }
    __syncthreads();
#pragma unroll
    for (int i = 0; i < 4; ++i) { const int t = 16 * tb + 4 * fq + i;
        const float r = rsqrtf((rsq[t] + rsq[64 + t]) * (1.f / 128.f) + RMS_EPS);
#pragma unroll
        for (int j = 0; j < 4; ++j) { const int v = 16 * (vh * 4 + j) + fr; const size_t idx = (size_t)(row0 + t) * 512 + h * 128 + v;
            OBF[idx] = f2bf_(o[j][i] * r * hgn[v] * bf2f(SGB[idx])); } }
    __syncthreads();
}
__device__ __forceinline__ void hs_unit(int u, const float* __restrict__ LOGF, const bf16* __restrict__ QB, const bf16* __restrict__ IB, const bf16* __restrict__ SGB, const float* __restrict__ s0,
                                        const float* __restrict__ hgn, bf16* __restrict__ OBF, float* __restrict__ sout, HG_LAS unsigned char* L) {
    const int tid = threadIdx.x, v = tid & 127, kq = tid >> 7, b = u >> 2, h = u & 3;
    HG_LAS float* fq_ = (HG_LAS float*)L;
    HG_LAS float* qq = fq_ + 512;
    HG_LAS float* red = qq + 512;
    HG_LAS float* rs2 = red + 512;
    __syncthreads();
    { const int t = tid >> 7, k = tid & 127; const size_t idx = (size_t)(MP + b * 4 + t) * 512 + h * 128 + k;
      fq_[tid] = __expf(LOGF[idx]); qq[tid] = bf2f(QB[idx]); }
    float S[32];
#pragma unroll
    for (int i = 0; i < 32; ++i) S[i] = s0[(size_t)u * 16384 + (32 * kq + i) * 128 + v];
    __syncthreads();
    for (int t = 0; t < 4; ++t) {
        const size_t idx = (size_t)(MP + b * 4 + t) * 512 + h * 128 + v;
        const float vv = bf2f(IB[idx]);
        float part = 0.f;
#pragma unroll
        for (int i = 0; i < 32; ++i) { const float f = fq_[t * 128 + 32 * kq + i]; S[i] = f * S[i] + (1.f - f) * vv; part += S[i] * qq[t * 128 + 32 * kq + i]; }
        red[kq * 128 + v] = part;
        __syncthreads();
        float o = 0.f, sq = 0.f;
        if (kq == 0) { o = (red[v] + red[128 + v]) + (red[256 + v] + red[384 + v]); sq = o * o;
#pragma unroll
            for (int m = 1; m < 64; m <<= 1) sq += __shfl_xor(sq, m);
            if ((tid & 63) == 0) rs2[tid >> 6] = sq; }
        __syncthreads();
        if (kq == 0) { const float r = rsqrtf((rs2[0] + rs2[1]) * (1.f / 128.f) + RMS_EPS); OBF[idx] = f2bf_(o * r * hgn[v] * bf2f(SGB[idx])); }
        __syncthreads();
    }
#pragma unroll
    for (int i = 0; i < 32; ++i) sout[(size_t)u * 16384 + (32 * kq + i) * 128 + v] = S[i];
}
#undef HG_MFMA
}
namespace dc {
typedef short h8 __attribute__((ext_vector_type(8)));
typedef float f4 __attribute__((ext_vector_type(4)));
typedef unsigned u4 __attribute__((ext_vector_type(4)));
constexpr int PSTR = 130;
constexpr float THR = 8.f;
__device__ __forceinline__ unsigned pk(float lo, float hi) { unsigned r; asm volatile("v_cvt_pk_bf16_f32 %0, %1, %2" : "=v"(r) : "v"(lo), "v"(hi)); return r; }
__device__ __forceinline__ h8 pack8(f4 a, f4 b) { u4 w = {pk(a[0], a[1]), pk(a[2], a[3]), pk(b[0], b[1]), pk(b[2], b[3])}; return __builtin_bit_cast(h8, w); }
#define DC_MFMA(a, b, c) __builtin_amdgcn_mfma_f32_16x16x32_bf16((a), (b), (c), 0, 0, 0)
__device__ __forceinline__ void dec_unit(int u, const float* __restrict__ QS, const float* __restrict__ ck, const float* __restrict__ cv, const int* __restrict__ pt, float* __restrict__ PART) {
    const int tid = threadIdx.x, lane = tid & 63, w = __builtin_amdgcn_readfirstlane(tid >> 6), fr = lane & 15, fq = lane >> 4;
    const int bh = u >> 1, half = u & 1, b = bh >> 2, h = bh & 3;
    h8 qf[4];
#pragma unroll
    for (int ks = 0; ks < 4; ++ks) {
        f4 a = {0.f, 0.f, 0.f, 0.f}, c = a;
        if (fr < 8 && (ks >> 1) == (fr & 1)) { const float* q = QS + (size_t)(b * 4 + (fr >> 1)) * 512 + h * 128 + 32 * ks + 8 * fq; a = *(const f4*)q; c = *(const f4*)(q + 4); }
        qf[ks] = pack8(a, c);
    }
    f4 o[8];
#pragma unroll
    for (int eb = 0; eb < 8; ++eb) o[eb] = (f4){0.f, 0.f, 0.f, 0.f};
    float m_run = -1e30f, l_run = 0.f;
    for (int pi = 0; pi < 4; ++pi) {
        const int pg = __builtin_amdgcn_readfirstlane(pt[b * NPG + half * 32 + w * 4 + pi]);
        const float* kp = ck + ((size_t)pg * PAGE) * 512 + h * 128;
        const float* vp = cv + ((size_t)pg * PAGE) * 512 + h * 128;
        for (int st = 0; st < 4; ++st) {
            f4 kr[2][4][2];
#pragma unroll
            for (int kt = 0; kt < 2; ++kt)
#pragma unroll
                for (int ks = 0; ks < 4; ++ks) { const float* p = kp + (size_t)(32 * st + 16 * kt + fr) * 512 + 32 * ks + 8 * fq; kr[kt][ks][0] = *(const f4*)p; kr[kt][ks][1] = *(const f4*)(p + 4); }
            float vr[8][8];
#pragma unroll
            for (int j = 0; j < 8; ++j) { const int key = 32 * st + (j < 4 ? 4 * fq + j : 12 + 4 * fq + j);
#pragma unroll
                for (int eb = 0; eb < 8; ++eb) vr[eb][j] = vp[(size_t)key * 512 + 16 * eb + fr]; }
            f4 s0 = {0.f, 0.f, 0.f, 0.f}, s1 = s0;
#pragma unroll
            for (int ks = 0; ks < 4; ++ks) { s0 = DC_MFMA(pack8(kr[0][ks][0], kr[0][ks][1]), qf[ks], s0); s1 = DC_MFMA(pack8(kr[1][ks][0], kr[1][ks][1]), qf[ks], s1); }
            float mx = fmaxf(fmaxf(fmaxf(s0[0], s0[1]), fmaxf(s0[2], s0[3])), fmaxf(fmaxf(s1[0], s1[1]), fmaxf(s1[2], s1[3])));
            mx = fmaxf(mx, __shfl_xor(mx, 16)); mx = fmaxf(mx, __shfl_xor(mx, 32));
            float mn = m_run;
            if (!__all((mx - m_run) <= THR)) {
                mn = fmaxf(m_run, mx); const float alpha = __builtin_amdgcn_exp2f(m_run - mn); m_run = mn; l_run *= alpha;
#pragma unroll
                for (int i = 0; i < 4; ++i) { const float a_lo = __shfl(alpha, i), a_hi = __shfl(alpha, 4 + i); const float a = (fq == 1) ? a_hi : a_lo;
#pragma unroll
                    for (int eb = 0; eb < 8; ++eb) o[eb][i] *= a; }
            }
            f4 p0, p1;
#pragma unroll
            for (int i = 0; i < 4; ++i) { p0[i] = __builtin_amdgcn_exp2f(s0[i] - mn); p1[i] = __builtin_amdgcn_exp2f(s1[i] - mn); }
            l_run += ((p0[0] + p0[1]) + (p0[2] + p0[3])) + ((p1[0] + p1[1]) + (p1[2] + p1[3]));
            const h8 pa = pack8(p0, p1);
#pragma unroll
            for (int eb = 0; eb < 8; ++eb) {
                u4 wv = {pk(vr[eb][0], vr[eb][1]), pk(vr[eb][2], vr[eb][3]), pk(vr[eb][4], vr[eb][5]), pk(vr[eb][6], vr[eb][7])};
                o[eb] = DC_MFMA(pa, __builtin_bit_cast(h8, wv), o[eb]);
            }
        }
    }
    l_run += __shfl_xor(l_run, 16); l_run += __shfl_xor(l_run, 32);
    float* P = PART + ((size_t)bh * 16 + half * 8 + w) * 8 * PSTR;
    if (fq < 2) {
#pragma unroll
        for (int i = 0; i < 4; ++i)
#pragma unroll
            for (int eb = 0; eb < 8; ++eb) P[(4 * fq + i) * PSTR + 16 * eb + fr] = o[eb][i];
    }
    if (lane < 8) { P[lane * PSTR + 128] = m_run; P[lane * PSTR + 129] = l_run; }
}
__device__ __forceinline__ void dec_combine(int r, int h, const float* __restrict__ PART, const float* __restrict__ QS, const float* __restrict__ KS, const float* __restrict__ VS, float lam, int lane, float& x0, float& x1) {
    const int b = r >> 2, t = r & 3, bh = b * 4 + h;
    float res[2][2];
#pragma unroll
    for (int m = 0; m < 2; ++m) {
        const int c = 2 * t + m;
        float sj[4];
#pragma unroll
        for (int j = 0; j < 4; ++j) {
            float pr = QS[(size_t)r * 512 + h * 128 + m * 64 + lane] * KS[(size_t)(b * 4 + j) * 512 + h * 128 + m * 64 + lane];
#pragma unroll
            for (int o_ = 1; o_ < 64; o_ <<= 1) pr += __shfl_xor(pr, o_);
            sj[j] = (j <= t) ? pr : -1e30f;
        }
        const float* P = PART + ((size_t)bh * 16) * 8 * PSTR + c * PSTR;
        float M = fmaxf(fmaxf(sj[0], sj[1]), fmaxf(sj[2], sj[3]));
        for (int p = 0; p < 16; ++p) M = fmaxf(M, P[(size_t)p * 8 * PSTR + 128]);
        float Ls = 0.f, a0 = 0.f, a1 = 0.f;
        for (int p = 0; p < 16; ++p) { const float* pp = P + (size_t)p * 8 * PSTR; const float wgt = __builtin_amdgcn_exp2f(pp[128] - M); Ls += pp[129] * wgt; a0 += pp[2 * lane] * wgt; a1 += pp[2 * lane + 1] * wgt; }
#pragma unroll
        for (int j = 0; j < 4; ++j) { const float wgt = (j <= t) ? __builtin_amdgcn_exp2f(sj[j] - M) : 0.f; Ls += wgt;
            a0 += wgt * VS[(size_t)(b * 4 + j) * 512 + h * 128 + 2 * lane]; a1 += wgt * VS[(size_t)(b * 4 + j) * 512 + h * 128 + 2 * lane + 1]; }
        res[m][0] = a0 / Ls; res[m][1] = a1 / Ls;
    }
    x0 = res[0][0] - lam * res[1][0]; x1 = res[0][1] - lam * res[1][1];
}
#undef DC_MFMA
}
namespace mk {
using pg8::bf16_t; using pg8::Unit; using pg8::Gemm; using pg8::StaticOrder; using pg8::cvt_pk_bf16;
typedef pg8::f32x4 f4; typedef pg8::u32x4 u4; typedef pg8::bf16x8 h8;
constexpr int NWAVES = 8;
constexpr int MPAD = 65 * 256;
constexpr size_t MiB = 1u << 20;
constexpr float C2Q = 0.125f * 1.4426950408889634f;
constexpr size_t FW_CTL = 0, CTL_ZERO_BYTES = 1 * MiB;
constexpr size_t FW_MISC = 1 * MiB;
constexpr size_t FW_ROPEC = 2 * MiB, FW_ROPES = 4 * MiB;
constexpr size_t FW_WIN = 6 * MiB, FW_WUP = 18 * MiB, FW_WDN = 30 * MiB, FW_WA = 36 * MiB, FW_WB = 37 * MiB, FW_WO = 38 * MiB;
constexpr size_t FW_XB = 40 * MiB;
constexpr size_t FW_QA = 74 * MiB, FW_KA = 90 * MiB;
constexpr size_t FW_VA = 106 * MiB;
constexpr size_t FW_QS = 122 * MiB;
constexpr size_t FW_QB = 123 * MiB, FW_IB = 140 * MiB, FW_SGB = 157 * MiB;
constexpr size_t FW_LOGF = 174 * MiB;
constexpr size_t FW_SGA = 207 * MiB, FW_SGG = 240 * MiB;
constexpr size_t FW_O12 = 273 * MiB;
constexpr size_t FW_DST = 305 * MiB;
constexpr size_t FW_DEC = 369 * MiB;
constexpr size_t FW_SCT = 370 * MiB;
constexpr size_t FW_OBF = 402 * MiB;
constexpr size_t FW_OAF = 419 * MiB;
constexpr size_t FW_TMP = 436 * MiB;
constexpr size_t FW_MG = 502 * MiB;
constexpr size_t FW_HPRE = 535 * MiB;
constexpr size_t FW_HF = 601 * MiB;
constexpr size_t FW_HB = 667 * MiB;
constexpr size_t FW_AB = 700 * MiB;
constexpr size_t FW_GB = 790 * MiB;
constexpr size_t FW_U = 880 * MiB;
constexpr size_t FW_Y = 970 * MiB;
constexpr size_t FW_PART = 1036 * MiB;
constexpr size_t FW_END = 1046 * MiB;
constexpr int CW_TMO = 0, CW_BAR = 4096;
constexpr int RING_OFF = 0, RING_BYTES = 131072, LDSCTL_OFF = RING_BYTES, MISC_OFF = LDSCTL_OFF + 320, LDS_BYTES = 147456;

struct Args { const float* in[26]; float* out; unsigned char* ws; unsigned char* fw; int ph_lo, ph_hi, li, pad; };

__device__ __forceinline__ float sigm(float x) { return 1.f / (1.f + __expf(-x)); }
__device__ __forceinline__ u4 pack8(f4 a, f4 b) { u4 w; w.x = cvt_pk_bf16(a[0], a[1]); w.y = cvt_pk_bf16(a[2], a[3]); w.z = cvt_pk_bf16(b[0], b[1]); w.w = cvt_pk_bf16(b[2], b[3]); return w; }

struct EpiInProj {
    static constexpr bool PERM = true, AFTER_DRAIN = false;
    bf16_t *QA, *KA, *VA, *QB, *IB, *SGB, *SGA, *SGG; float *LOGF, *QS; float* out; const float *rc, *rs, *lb;
    __device__ __forceinline__ void operator()(const f4 (&acc)[2][2][4][2], const Unit& u, int wr, int wc, int fr, int fq) const {
        const int pn = u.pn; const bool samp = u.pm >= 64;
        const int cu = wc * 32 + 8 * fq;
#pragma unroll
        for (int ai = 0; ai < 2; ++ai) {
            if (!(samp && ai == 1)) {
#pragma unroll
            for (int m = 0; m < 4; ++m) {
                const int row = u.pm * 256 + ai * 128 + wr * 64 + m * 16 + fr;
                const int srow = row - MP;
                if (pn < 4) {
                    const int pos = samp ? PAST + (srow & 3) : (row & (SEQ - 1));
                    const int mm = wc >> 1, j0 = (wc & 1) * 32 + 8 * fq, i0 = j0 >> 1;
                    const f4 c = *(const f4*)(rc + (size_t)pos * 32 + i0), s = *(const f4*)(rs + (size_t)pos * 32 + i0);
#pragma unroll
                    for (int bj = 0; bj < 2; ++bj) {
                        const f4 v0 = acc[ai][bj][m][0], v1 = acc[ai][bj][m][1];
                        const f4 x1 = {v0[0], v0[2], v1[0], v1[2]}, x2 = {v0[1], v0[3], v1[1], v1[3]};
                        f4 r1 = x1 * c - x2 * s, r2 = x2 * c + x1 * s;
                        const int h = (pn & 1) * 2 + bj;
                        if (pn < 2) { r1 = r1 * C2Q; r2 = r2 * C2Q; }
                        if (!samp) {
                            const int b = row >> 13, t = row & (SEQ - 1);
                            bf16_t* dst = (pn < 2 ? QA : KA) + ((size_t)(((b * 4 + h) * 2 + mm) * SEQ + t)) * 64 + j0;
                            const f4 lo = {r1[0], r2[0], r1[1], r2[1]}, hi = {r1[2], r2[2], r1[3], r2[3]};
                            *(u4*)dst = pack8(lo, hi);
                            if (pn >= 2) { float* o = out + O_KP + (size_t)row * 512 + h * 128 + mm * 64 + i0; *(f4*)o = r1; *(f4*)(o + 32) = r2; }
                        } else {
                            float* o = (pn < 2 ? QS : out + O_KS) + (size_t)srow * 512 + h * 128 + mm * 64 + i0; *(f4*)o = r1; *(f4*)(o + 32) = r2;
                        }
                    }
                } else {
#pragma unroll
                    for (int bj = 0; bj < 2; ++bj) {
                        f4 v0 = acc[ai][bj][m][0], v1 = acc[ai][bj][m][1];
                        if (pn < 14) {
                            const int sc = (pn & 1) * 256 + bj * 128 + cu;
                            if (pn < 6) {
                                if (!samp) {
                                    const int b = row >> 13, t = row & (SEQ - 1), h = sc >> 7;
                                    *(u4*)(VA + ((size_t)((b * 4 + h) * SEQ + t)) * 128 + (sc & 127)) = pack8(v0, v1);
                                    float* o = out + O_VP + (size_t)row * 512 + sc; *(f4*)o = v0; *(f4*)(o + 4) = v1;
                                } else { float* o = out + O_VS + (size_t)srow * 512 + sc; *(f4*)o = v0; *(f4*)(o + 4) = v1; }
                            } else if (pn < 8) {
                                *(u4*)(QB + (size_t)row * 512 + sc) = pack8(v0, v1);
                            } else if (pn < 10) {
                                const f4 l0 = *(const f4*)(lb + sc), l1 = *(const f4*)(lb + sc + 4);
#pragma unroll
                                for (int e = 0; e < 4; ++e) { v0[e] = logf(l0[e] + (1.f - l0[e]) / (1.f + expf(-v0[e]))); v1[e] = logf(l1[e] + (1.f - l1[e]) / (1.f + expf(-v1[e]))); }
                                float* o = LOGF + (size_t)row * 512 + sc; *(f4*)o = v0; *(f4*)(o + 4) = v1;
                            } else if (pn < 12) {
                                *(u4*)(IB + (size_t)row * 512 + sc) = pack8(v0, v1);
                            } else {
#pragma unroll
                                for (int e = 0; e < 4; ++e) { v0[e] = v0[e] * sigm(v0[e]); v1[e] = v1[e] * sigm(v1[e]); }
                                *(u4*)(SGB + (size_t)row * 512 + sc) = pack8(v0, v1);
                            }
                        } else {
                            const int sc = ((pn - 14) & 3) * 256 + bj * 128 + cu;
#pragma unroll
                            for (int e = 0; e < 4; ++e) { v0[e] = sigm(v0[e]); v1[e] = sigm(v1[e]); }
                            *(u4*)((pn < 18 ? SGA : SGG) + (size_t)row * 1024 + sc) = pack8(v0, v1);
                        }
                    }
                }
            } }
        }
    }
};


__device__ __forceinline__ f4 bflo4(unsigned a, unsigned b) { return (f4){__uint_as_float(a << 16), __uint_as_float(a & 0xffff0000u), __uint_as_float(b << 16), __uint_as_float(b & 0xffff0000u)}; }
struct EpiMergeA {
    static constexpr bool PERM = true, AFTER_DRAIN = false;
    const bf16_t* SG; float* TMP;
    __device__ __forceinline__ void operator()(const f4 (&acc)[2][2][4][2], const Unit& u, int wr, int wc, int fr, int fq) const {
#pragma unroll
        for (int ai = 0; ai < 2; ++ai)
#pragma unroll
            for (int m = 0; m < 4; ++m) { const size_t row = (size_t)(u.pm * 256 + ai * 128 + wr * 64 + m * 16 + fr);
#pragma unroll
                for (int bj = 0; bj < 2; ++bj) { const size_t idx = row * 1024 + u.pn * 256 + bj * 128 + wc * 32 + 8 * fq;
                    const u4 g = *(const u4*)(SG + idx);
                    *(f4*)(TMP + idx) = acc[ai][bj][m][0] * bflo4(g.x, g.y); *(f4*)(TMP + idx + 4) = acc[ai][bj][m][1] * bflo4(g.z, g.w); } }
    }
};
struct EpiMergeB {
    static constexpr bool PERM = true, AFTER_DRAIN = false;
    const bf16_t* SG; const float* TMP; bf16_t* MG;
    __device__ __forceinline__ void operator()(const f4 (&acc)[2][2][4][2], const Unit& u, int wr, int wc, int fr, int fq) const {
#pragma unroll
        for (int ai = 0; ai < 2; ++ai)
#pragma unroll
            for (int m = 0; m < 4; ++m) { const size_t row = (size_t)(u.pm * 256 + ai * 128 + wr * 64 + m * 16 + fr);
#pragma unroll
                for (int bj = 0; bj < 2; ++bj) { const size_t idx = row * 1024 + u.pn * 256 + bj * 128 + wc * 32 + 8 * fq;
                    const u4 g = *(const u4*)(SG + idx);
                    const f4 t0 = *(const f4*)(TMP + idx), t1 = *(const f4*)(TMP + idx + 4);
                    *(u4*)(MG + idx) = pack8(t0 + acc[ai][bj][m][0] * bflo4(g.x, g.y), t1 + acc[ai][bj][m][1] * bflo4(g.z, g.w)); } }
    }
};
struct EpiF32 {
    static constexpr bool PERM = true, AFTER_DRAIN = false;
    float* O;
    __device__ __forceinline__ void operator()(const f4 (&acc)[2][2][4][2], const Unit& u, int wr, int wc, int fr, int fq) const {
#pragma unroll
        for (int ai = 0; ai < 2; ++ai)
#pragma unroll
            for (int m = 0; m < 4; ++m) { const size_t row = (size_t)(u.pm * 256 + ai * 128 + wr * 64 + m * 16 + fr);
#pragma unroll
                for (int bj = 0; bj < 2; ++bj) { const size_t idx = row * 1024 + u.pn * 256 + bj * 128 + wc * 32 + 8 * fq;
                    *(f4*)(O + idx) = acc[ai][bj][m][0]; *(f4*)(O + idx + 4) = acc[ai][bj][m][1]; } }
    }
};
struct EpiUp {
    static constexpr bool PERM = true, AFTER_DRAIN = false;
    bf16_t *AB, *GB; float* out;
    __device__ __forceinline__ void operator()(const f4 (&acc)[2][2][4][2], const Unit& u, int wr, int wc, int fr, int fq) const {
        const int j0 = u.pn * 128 + wc * 32 + 8 * fq;
#pragma unroll
        for (int ai = 0; ai < 2; ++ai)
#pragma unroll
            for (int m = 0; m < 4; ++m) { const int row = u.pm * 256 + ai * 128 + wr * 64 + m * 16 + fr; const size_t idx = (size_t)row * DFF + j0;
                *(u4*)(AB + idx) = pack8(acc[ai][0][m][0], acc[ai][0][m][1]);
                *(u4*)(GB + idx) = pack8(acc[ai][1][m][0], acc[ai][1][m][1]);
                float* cs = nullptr;
                if (row < MP) { const int t = row & (SEQ - 1); if (t >= SEQ - 2) cs = out + O_CP + ((size_t)(row >> 13) * 2 + (t - (SEQ - 2))) * DFF + j0; }
                else if (row < MT) { const int r = row - MP, t = r & 3; if (t >= 2) cs = out + O_CS + ((size_t)(r >> 2) * 2 + (t - 2)) * DFF + j0; }
                if (cs) { *(f4*)cs = acc[ai][0][m][0]; *(f4*)(cs + 4) = acc[ai][0][m][1]; } }
    }
};
__device__ __forceinline__ float wave_sum(float v) {
#pragma unroll
    for (int o = 1; o < 64; o <<= 1) v += __shfl_xor(v, o);
    return v;
}
__device__ __forceinline__ void ln_row(const float* res, const float* pre, const float* g, const float* b, float* outf, bf16_t* outb, int lane) {
    f4 v[4]; float s = 0.f;
#pragma unroll
    for (int j = 0; j < 4; ++j) { v[j] = *(const f4*)(res + 4 * lane + 256 * j) * ALPHA + *(const f4*)(pre + 4 * lane + 256 * j); s += (v[j][0] + v[j][1]) + (v[j][2] + v[j][3]); }
    const float mean = wave_sum(s) * (1.f / DM); float q = 0.f;
#pragma unroll
    for (int j = 0; j < 4; ++j) { v[j] = v[j] - mean; q += (v[j][0] * v[j][0] + v[j][1] * v[j][1]) + (v[j][2] * v[j][2] + v[j][3] * v[j][3]); }
    const float rstd = rsqrtf(wave_sum(q) * (1.f / DM) + LN_EPS);
#pragma unroll
    for (int j = 0; j < 4; ++j) { const f4 y = v[j] * rstd * *(const f4*)(g + 4 * lane + 256 * j) + *(const f4*)(b + 4 * lane + 256 * j);
        *(f4*)(outf + 4 * lane + 256 * j) = y;
        if (outb) { unsigned long long w = (unsigned long long)cvt_pk_bf16(y[0], y[1]) | ((unsigned long long)cvt_pk_bf16(y[2], y[3]) << 32); *(unsigned long long*)(outb + 4 * lane + 256 * j) = w; } }
}

template <int MODE> __device__ __forceinline__ int wmap(int n) {
    if (MODE == 1) { if (n < 1024) { const int d = n & 63; return (n & ~63) + 2 * (d & 31) + (d >> 5); } return n; }
    if (MODE == 2) { const int g = n >= DFF, j = g ? n - DFF : n; return (j >> 7) * 256 + g * 128 + (j & 127); }
    return n;
}
template <int MODE> __device__ __forceinline__ void p0_transpose_item(const float* W, int K, int N, bf16_t* WT, LAS float* scr, int item, int lane) {
    const int nblk = N / 32, kb = item / nblk, nb = item % nblk, k0 = 64 * kb, n0 = 32 * nb;
#pragma unroll 8
    for (int i = 0; i < 32; ++i) { const int kk = 2 * i + (lane >> 5); scr[kk * 33 + (lane & 31)] = W[(size_t)(k0 + kk) * N + n0 + (lane & 31)]; }
    LDS_WAIT(); asm volatile("" ::: "memory");
    const int c = lane & 7;
#pragma unroll
    for (int j = 0; j < 4; ++j) { const int n = (lane >> 3) + 8 * j; const LAS float* s = scr + (8 * c) * 33 + n;
        v4u o; o.x = pk2(s[0 * 33], s[1 * 33]); o.y = pk2(s[2 * 33], s[3 * 33]); o.z = pk2(s[4 * 33], s[5 * 33]); o.w = pk2(s[6 * 33], s[7 * 33]);
        *(GAS v4u*)(WT + (size_t)wmap<MODE>(n0 + n) * K + k0 + 8 * c) = o; }
    LDS_WAIT(); asm volatile("" ::: "memory");
}

__global__ void __launch_bounds__(NWAVES * 64, 2) mk_fwd(Args args) {
    extern __shared__ __attribute__((aligned(16))) unsigned char lds[];
    LAS unsigned char* L = (LAS unsigned char*)lds;
    volatile LAS unsigned* MISC = (volatile LAS unsigned*)(L + MISC_OFF);
    const int tid = threadIdx.x, lane = tid & 63, wave = __builtin_amdgcn_readfirstlane(tid >> 6);
    const int G = gridDim.x, bx = blockIdx.x;
    const int vcu = (G % 8 == 0) ? (bx % 8) * (G / 8) + bx / 8 : bx;
    unsigned char* fw = args.fw;
    gu32* ctl = (gu32*)(fw + FW_CTL);
    for (int u = tid; u < (LDS_BYTES - LDSCTL_OFF) / 4; u += NWAVES * 64) ((LAS unsigned*)(L + LDSCTL_OFF))[u] = 0u;
    __syncthreads();
    XcdBarrier bar = xcd_barrier_post((unsigned*)(ctl + CW_BAR) + args.li * XCD_BAR_WORDS, MISC + 8);
    const int lo = args.ph_lo, hi = args.ph_hi;
#define IN(k) (lo <= (k) && (k) < hi)
#define BOTH(k) (IN(k) && IN((k) + 1))
    float* out = args.out;
    float* misc = (float*)(fw + FW_MISC); float* ropec = (float*)(fw + FW_ROPEC); float* ropes = (float*)(fw + FW_ROPES);
    bf16_t* WIN = (bf16_t*)(fw + FW_WIN); bf16_t* WUP = (bf16_t*)(fw + FW_WUP); bf16_t* WDN = (bf16_t*)(fw + FW_WDN);
    bf16_t* WA = (bf16_t*)(fw + FW_WA); bf16_t* WB = (bf16_t*)(fw + FW_WB); bf16_t* WO = (bf16_t*)(fw + FW_WO);
    bf16_t* XB = (bf16_t*)(fw + FW_XB);

    if (IN(0)) {
        LAS float* scr = (LAS float*)(L + RING_OFF + wave * 16384);
        const int gw = vcu * NWAVES + wave, NGW = G * NWAVES;
        constexpr int I_IN = (DM / 64) * (INC / 32), I_UP = I_IN, I_DN = (DFF / 64) * (DM / 32), I_A = (512 / 64) * (DM / 32), I_O = (DM / 64) * (DM / 32);
        constexpr int NITEMS = I_IN + I_UP + I_DN + 2 * I_A + I_O;
        for (int it = gw; it < NITEMS; it += NGW) {
            int r = it;
            if (r < I_IN) { p0_transpose_item<1>(args.in[7], DM, INC, WIN, scr, r, lane); continue; } r -= I_IN;
            if (r < I_UP) { p0_transpose_item<2>(args.in[20], DM, INC, WUP, scr, r, lane); continue; } r -= I_UP;
            if (r < I_DN) { p0_transpose_item<0>(args.in[23], DFF, DM, WDN, scr, r, lane); continue; } r -= I_DN;
            if (r < I_A) { p0_transpose_item<0>(args.in[15], 512, DM, WA, scr, r, lane); continue; } r -= I_A;
            if (r < I_A) { p0_transpose_item<0>(args.in[16], 512, DM, WB, scr, r, lane); continue; } r -= I_A;
            p0_transpose_item<0>(args.in[17], DM, DM, WO, scr, r, lane);
        }
        for (int m = gw; m < MPAD; m += NGW) {
            GAS unsigned long long* o8 = (GAS unsigned long long*)(XB + (size_t)m * DM) + lane;
            if (m < MT) {
                const float* xr = m < MP ? args.in[0] + (size_t)m * DM : args.in[1] + (size_t)(m - MP) * DM;
                const GAS f32x4* x4 = (const GAS f32x4*)xr + lane;
#pragma unroll
                for (int j = 0; j < 4; ++j) { const f32x4 v = x4[64 * j]; o8[64 * j] = (unsigned long long)pk2(v.x, v.y) | ((unsigned long long)pk2(v.z, v.w) << 32); }
            } else {
#pragma unroll
                for (int j = 0; j < 4; ++j) o8[64 * j] = 0ull;
            }
        }
        const int gid = vcu * (NWAVES * 64) + tid;
        if (gid == 0) {
            float s1 = 0.f, s2 = 0.f;
            for (int i = 0; i < 64; ++i) { s1 += args.in[8][i] * args.in[9][i]; s2 += args.in[10][i] * args.in[11][i]; }
            misc[0] = expf(s1) - expf(s2) + LAM_INIT;
        }
        if (gid < 512) { const float a = args.in[13][gid], b = args.in[13][512 + gid], mx = fmaxf(a, b), ea = expf(a - mx), eb = expf(b - mx); misc[64 + gid] = ea / (ea + eb); }
        for (int e = gid; e < 8196 * 32; e += G * NWAVES * 64) {
            const int pos = e >> 5, i = e & 31;
            const float inv = powf(10000.0f, -(float)i * 2.0f / 64.0f), ang = (float)pos * inv;
            ropec[e] = cosf(ang); ropes[e] = sinf(ang);
        }
        if (BOTH(0)) xcd_barrier(bar);
    }
    if (IN(1)) {
        Gemm g{XB, WIN, MPAD, INC, DM}; StaticOrder S; S.init(MPAD, INC, G, bx);
        EpiInProj E{(bf16_t*)(fw + FW_QA), (bf16_t*)(fw + FW_KA), (bf16_t*)(fw + FW_VA), (bf16_t*)(fw + FW_QB), (bf16_t*)(fw + FW_IB), (bf16_t*)(fw + FW_SGB),
                    (bf16_t*)(fw + FW_SGA), (bf16_t*)(fw + FW_SGG), (float*)(fw + FW_LOGF), (float*)(fw + FW_QS), out, ropec, ropes, misc + 64};
        pg8::gemm_phase<EpiInProj, StaticOrder, true, true>(L + RING_OFF, g, S, E);
        if (BOTH(1)) xcd_barrier(bar);
    }
    if (IN(2)) {
        for (int cu = vcu; cu < 1024; cu += G) hg::h1_unit(cu, (const float*)(fw + FW_LOGF), (const hg::bf16*)(fw + FW_IB), (float*)(fw + FW_DST), (float*)(fw + FW_DEC), L + RING_OFF);
        if (BOTH(2)) xcd_barrier(bar);
    }
    if (IN(3)) {
        for (int g = bx * (NWAVES * 64) + tid; g < 131072; g += G * NWAVES * 64) hg::h2_scan(g, (const float*)(fw + FW_DST), (const float*)(fw + FW_DEC), (hg::bf16*)(fw + FW_SCT), out + O_HP);
        if (BOTH(3)) xcd_barrier(bar);
    }
    if (IN(4)) {
        static_assert(at2::LDS_BYTES <= RING_BYTES, "attention LDS");
        const bool dec_first = (vcu & 1) != 0;
        if (dec_first) for (int u = vcu; u < 256; u += G) dc::dec_unit(u, (const float*)(fw + FW_QS), args.in[2], args.in[3], (const int*)args.in[6], (float*)(fw + FW_PART));
        at2::attn_phase((char*)lds + RING_OFF, (const at2::bf16*)(fw + FW_QA), (const at2::bf16*)(fw + FW_KA), (const at2::bf16*)(fw + FW_VA), (at2::bf16*)(fw + FW_O12), vcu, G);
        for (int cu = vcu; cu < 1024; cu += G) hg::h3_unit(cu, (const float*)(fw + FW_LOGF), (const hg::bf16*)(fw + FW_QB), (const hg::bf16*)(fw + FW_IB), (const hg::bf16*)(fw + FW_SGB), (const hg::bf16*)(fw + FW_SCT),
                                                           args.in[14], (hg::bf16*)(fw + FW_OBF), L + RING_OFF);
        for (int u = vcu; u < 128; u += G) hg::hs_unit(u, (const float*)(fw + FW_LOGF), (const hg::bf16*)(fw + FW_QB), (const hg::bf16*)(fw + FW_IB), (const hg::bf16*)(fw + FW_SGB), args.in[4],
                                                        args.in[14], (hg::bf16*)(fw + FW_OBF), out + O_HS, L + RING_OFF);
        if (!dec_first) for (int u = vcu; u < 256; u += G) dc::dec_unit(u, (const float*)(fw + FW_QS), args.in[2], args.in[3], (const int*)args.in[6], (float*)(fw + FW_PART));
        if (BOTH(4)) xcd_barrier(bar);
    }
    if (IN(5)) {
        const float lam = misc[0]; const bf16_t* O12 = (const bf16_t*)(fw + FW_O12); bf16_t* OAF = (bf16_t*)(fw + FW_OAF); const float* sg = args.in[12];
        const int gw = vcu * NWAVES + wave, NGW = G * NWAVES;
        const float g0 = sg[2 * lane] * (1.f - LAM_INIT), g1 = sg[2 * lane + 1] * (1.f - LAM_INIT);
        for (int it = gw; it < MS * 4; it += NGW) {
            const int r = it >> 2, h = it & 3; float x0, x1;
            dc::dec_combine(r, h, (const float*)(fw + FW_PART), (const float*)(fw + FW_QS), out + O_KS, out + O_VS, lam, lane, x0, x1);
            const float rr = rsqrtf(wave_sum(x0 * x0 + x1 * x1) * (1.f / 128.f) + RMS_EPS);
            *(unsigned*)(OAF + (size_t)(MP + r) * 512 + h * 128 + 2 * lane) = cvt_pk_bf16(x0 * rr * g0, x1 * rr * g1);
        }
        for (int it = gw; it < MP * 4; it += NGW) {
            const int row = it >> 2, h = it & 3, b = row >> 13, t = row & (SEQ - 1);
            const unsigned u1 = *(const unsigned*)(O12 + ((size_t)(((b * 4 + h) * 2 + 0) * SEQ + t)) * 128 + 2 * lane), u2 = *(const unsigned*)(O12 + ((size_t)(((b * 4 + h) * 2 + 1) * SEQ + t)) * 128 + 2 * lane);
            const float x0 = __uint_as_float(u1 << 16) - lam * __uint_as_float(u2 << 16), x1 = __uint_as_float(u1 & 0xffff0000u) - lam * __uint_as_float(u2 & 0xffff0000u);
            const float r = rsqrtf(wave_sum(x0 * x0 + x1 * x1) * (1.f / 128.f) + RMS_EPS);
            *(unsigned*)(OAF + (size_t)row * 512 + h * 128 + 2 * lane) = cvt_pk_bf16(x0 * r * g0, x1 * r * g1);
        }
        if (BOTH(5)) xcd_barrier(bar);
    }
    if (IN(6)) {
        { Gemm g{(const bf16_t*)(fw + FW_OAF), WA, MPAD, DM, 512}; StaticOrder S; S.init(MPAD, DM, G, bx);
          EpiMergeA E{(const bf16_t*)(fw + FW_SGA), (float*)(fw + FW_TMP)};
          pg8::gemm_phase<EpiMergeA, StaticOrder, true, true>(L + RING_OFF, g, S, E); }
        __syncthreads();
        { Gemm g{(const bf16_t*)(fw + FW_OBF), WB, MPAD, DM, 512}; StaticOrder S; S.init(MPAD, DM, G, bx);
          EpiMergeB E{(const bf16_t*)(fw + FW_SGG), (const float*)(fw + FW_TMP), (bf16_t*)(fw + FW_MG)};
          pg8::gemm_phase<EpiMergeB, StaticOrder, true, true>(L + RING_OFF, g, S, E); }
        if (BOTH(6)) xcd_barrier(bar);
    }
    if (IN(7)) {
        Gemm g{(const bf16_t*)(fw + FW_MG), WO, MPAD, DM, DM}; StaticOrder S; S.init(MPAD, DM, G, bx);
        EpiF32 E{(float*)(fw + FW_HPRE)};
        pg8::gemm_phase<EpiF32, StaticOrder, true, true>(L + RING_OFF, g, S, E);
        if (BOTH(7)) xcd_barrier(bar);
    }
    if (IN(8)) {
        const int gw = vcu * NWAVES + wave, NGW = G * NWAVES;
        for (int m = gw; m < MT; m += NGW) {
            const float* xr = m < MP ? args.in[0] + (size_t)m * DM : args.in[1] + (size_t)(m - MP) * DM;
            ln_row(xr, (const float*)(fw + FW_HPRE) + (size_t)m * DM, args.in[18], args.in[19], (float*)(fw + FW_HF) + (size_t)m * DM, (bf16_t*)(fw + FW_HB) + (size_t)m * DM, lane);
        }
        if (BOTH(8)) xcd_barrier(bar);
    }
    if (IN(9)) {
        Gemm g{(const bf16_t*)(fw + FW_HB), WUP, MPAD, INC, DM}; StaticOrder S; S.init(MPAD, INC, G, bx);
        EpiUp E{(bf16_t*)(fw + FW_AB), (bf16_t*)(fw + FW_GB), out};
        pg8::gemm_phase<EpiUp, StaticOrder, true, true>(L + RING_OFF, g, S, E);
        if (BOTH(9)) xcd_barrier(bar);
    }
    if (IN(10)) {
        const int gw = vcu * NWAVES + wave, NGW = G * NWAVES;
        const bf16_t* AB = (const bf16_t*)(fw + FW_AB); const bf16_t* GB = (const bf16_t*)(fw + FW_GB); bf16_t* U = (bf16_t*)(fw + FW_U);
        const float* cw = args.in[21]; const float* cb = args.in[22]; const float* sc = args.in[5];
        for (int row = gw; row < MT; row += NGW) {
            int t; const float* c0 = nullptr;
            if (row < MP) t = row & (SEQ - 1); else { const int r = row - MP; t = r & 3; c0 = sc + (size_t)(r >> 2) * 2 * DFF; }
            for (int ch = lane; ch < DFF / 8; ch += 64) {
                const int j0 = ch * 8;
                const u4 a0 = *(const u4*)(AB + (size_t)row * DFF + j0), gg = *(const u4*)(GB + (size_t)row * DFF + j0);
                f4 p1lo, p1hi, p2lo, p2hi;
                if (t >= 1) { const u4 a1 = *(const u4*)(AB + (size_t)(row - 1) * DFF + j0); p1lo = bflo4(a1.x, a1.y); p1hi = bflo4(a1.z, a1.w); }
                else if (c0) { p1lo = *(const f4*)(c0 + DFF + j0); p1hi = *(const f4*)(c0 + DFF + j0 + 4); } else { p1lo = (f4){0.f, 0.f, 0.f, 0.f}; p1hi = p1lo; }
                if (t >= 2) { const u4 a2 = *(const u4*)(AB + (size_t)(row - 2) * DFF + j0); p2lo = bflo4(a2.x, a2.y); p2hi = bflo4(a2.z, a2.w); }
                else if (c0) { p2lo = *(const f4*)(c0 + (size_t)t * DFF + j0); p2hi = *(const f4*)(c0 + (size_t)t * DFF + j0 + 4); } else { p2lo = (f4){0.f, 0.f, 0.f, 0.f}; p2hi = p2lo; }
                f4 clo = *(const f4*)(cb + j0) + *(const f4*)(cw + j0) * p2lo + *(const f4*)(cw + DFF + j0) * p1lo + *(const f4*)(cw + 2 * DFF + j0) * bflo4(a0.x, a0.y);
                f4 chi = *(const f4*)(cb + j0 + 4) + *(const f4*)(cw + j0 + 4) * p2hi + *(const f4*)(cw + DFF + j0 + 4) * p1hi + *(const f4*)(cw + 2 * DFF + j0 + 4) * bflo4(a0.z, a0.w);
                const pg8::f32x2 e0 = pg8::gelu_pk((pg8::f32x2){clo[0], clo[1]}), e1 = pg8::gelu_pk((pg8::f32x2){clo[2], clo[3]}), e2 = pg8::gelu_pk((pg8::f32x2){chi[0], chi[1]}), e3 = pg8::gelu_pk((pg8::f32x2){chi[2], chi[3]});
                const f4 glo = bflo4(gg.x, gg.y), ghi = bflo4(gg.z, gg.w);
                *(u4*)(U + (size_t)row * DFF + j0) = pack8((f4){e0.x, e0.y, e1.x, e1.y} * glo, (f4){e2.x, e2.y, e3.x, e3.y} * ghi);
            }
        }
        if (BOTH(10)) xcd_barrier(bar);
    }
    if (IN(11)) {
        Gemm g{(const bf16_t*)(fw + FW_U), WDN, MPAD, DM, DFF}; StaticOrder S; S.init(MPAD, DM, G, bx);
        EpiF32 E{(float*)(fw + FW_Y)};
        pg8::gemm_phase<EpiF32, StaticOrder, true, true>(L + RING_OFF, g, S, E);
        if (BOTH(11)) xcd_barrier(bar);
    }
    if (IN(12)) {
        const int gw = vcu * NWAVES + wave, NGW = G * NWAVES;
        for (int m = gw; m < MT; m += NGW)
            ln_row((const float*)(fw + FW_HF) + (size_t)m * DM, (const float*)(fw + FW_Y) + (size_t)m * DM, args.in[24], args.in[25], m < MP ? out + O_YP + (size_t)m * DM : out + O_YS + (size_t)(m - MP) * DM, nullptr, lane);
    }
#undef IN
#undef BOTH
}
}
extern "C" void kernel_launch(void* const* d_in, const int* in_sizes, int n_in, void* d_out, int out_size, void* d_ws, size_t ws_size, hipStream_t stream) {
    if (n_in != 26 || (size_t)out_size != O_END || ws_size < mk::FW_END) { fprintf(stderr, "kernel_launch: unexpected sizes n_in %d out %d ws %zu (need %zu)\n", n_in, out_size, ws_size, (size_t)mk::FW_END); return; }
    static int grid = 0;
    if (grid == 0) {
        int dev = 0, cus = 0, per_cu = 0;
        if (hipGetDevice(&dev) != hipSuccess || hipDeviceGetAttribute(&cus, hipDeviceAttributeMultiprocessorCount, dev) != hipSuccess) { fprintf(stderr, "kernel_launch: device query failed\n"); grid = -1; return; }
        if (hipFuncSetAttribute((const void*)mk::mk_fwd, hipFuncAttributeMaxDynamicSharedMemorySize, mk::LDS_BYTES) != hipSuccess) { fprintf(stderr, "kernel_launch: hipFuncSetAttribute failed\n"); grid = -1; return; }
        if (hipOccupancyMaxActiveBlocksPerMultiprocessor(&per_cu, (const void*)mk::mk_fwd, mk::NWAVES * 64, mk::LDS_BYTES) != hipSuccess || per_cu < 1) { fprintf(stderr, "kernel_launch: occupancy query says %d\n", per_cu); }
        (void)hipGetLastError();
        grid = cus;
    }
    if (grid < 0) return;
    unsigned char* fw = (unsigned char*)d_ws;
    (void)hipMemsetAsync(fw + mk::FW_CTL, 0, mk::CTL_ZERO_BYTES, stream);
    mk::Args a{};
    for (int i = 0; i < 26; ++i) a.in[i] = (const float*)d_in[i];
    a.out = (float*)d_out; a.ws = (unsigned char*)d_ws; a.fw = fw; a.ph_lo = 0; a.ph_hi = 13; a.li = 0; a.pad = 0;
    hipLaunchKernelGGL(mk::mk_fwd, dim3(grid), dim3(mk::NWAVES * 64), mk::LDS_BYTES, stream, a);
}
```
